# Optimizing an MI355X kernel written in HIP

```python
import jax, jax.numpy as jnp
from jax import lax
import numpy as np

D_MODEL = 1024
BATCH = 2
SEQ = 16384
DEPTH = 1
DEC_BATCH = 1
DEC_SEQ = 16384
PAST_LEN = 128

MIX_WIDTH = D_MODEL
FNET_WIDTH = MIX_WIDTH // 2
LRU_WIDTH = MIX_WIDTH - FNET_WIDTH
FNET_GROUPS = 8
FNET_GROUP_DIM = FNET_WIDTH // FNET_GROUPS
LRU_HEADS = 8
LRU_HEAD_DIM = LRU_WIDTH // LRU_HEADS
CONV_WIDTH = 4
CONV_LEFT = CONV_WIDTH // 2
RGLRU_C = 8.0
IN_WIDTH = FNET_WIDTH + 2 * LRU_WIDTH
PEER_HEADS = 8
PEER_NKEYS = 128
PEER_EXPERTS = PEER_NKEYS * PEER_NKEYS
PEER_KEY_DIM = 128
PEER_TOPK = 16
PEER_CHUNK = 128
NORM_EPS = 1e-6

kernel_name = "hybrid_fnet_rglru_peer_encoder"


def rmsnorm(x, g):
    xf = x.astype(jnp.float32)
    y = xf * lax.rsqrt(jnp.mean(xf * xf, axis=-1, keepdims=True) + NORM_EPS)
    return (y * g.astype(jnp.float32)).astype(x.dtype)


def fnet_mixer(u, fnet_w):
    B, S, _ = u.shape
    ug = u.reshape(B, S, FNET_GROUPS, FNET_GROUP_DIM).astype(jnp.float32)
    f = jnp.fft.fft2(ug, axes=(1, 3), norm="ortho").real.astype(u.dtype)
    y = jnp.einsum('bsgc,gcd->bsgd', f, fnet_w)
    return y.reshape(B, S, FNET_WIDTH)


def centred_conv(u, conv_w, conv_b):
    S = u.shape[1]
    up = jnp.pad(u, ((0, 0), (CONV_LEFT, CONV_WIDTH - 1 - CONV_LEFT), (0, 0)))
    y = up[:, 0:S] * conv_w[0]
    for k in range(1, CONV_WIDTH):
        y = y + up[:, k:k + S] * conv_w[k]
    return y + conv_b


def _lin_combine(left, right):
    a1, b1 = left
    a2, b2 = right
    return a1 * a2, a2 * b1 + b2


def rglru_direction(xr, wa, ba, wx, bx, lam, reverse):
    B, S, W = xr.shape
    xh = xr.reshape(B, S, LRU_HEADS, LRU_HEAD_DIM)
    r = jax.nn.sigmoid(jnp.einsum('bshi,hij->bshj', xh, wa) + ba).reshape(B, S, W).astype(jnp.float32)
    i = jax.nn.sigmoid(jnp.einsum('bshi,hij->bshj', xh, wx) + bx).reshape(B, S, W).astype(jnp.float32)
    log_a = -RGLRU_C * jax.nn.softplus(-lam.astype(jnp.float32)) * r
    a = jnp.exp(log_a)
    b = jnp.sqrt(-jnp.expm1(2.0 * log_a)) * i * xr.astype(jnp.float32)
    _, h = lax.associative_scan(_lin_combine, (a, b), axis=1, reverse=reverse)
    return h


def peer_ffn(h, peer_wq, peer_k1, peer_k2, peer_u, peer_v):
    B, S, D = h.shape
    n_chunks = S // PEER_CHUNK
    hc = h.reshape(B, n_chunks, PEER_CHUNK, D).transpose(1, 0, 2, 3)

    def one_chunk(hb):
        q = (hb @ peer_wq).reshape(B, PEER_CHUNK, PEER_HEADS, 2, PEER_KEY_DIM)
        s1 = jnp.einsum('bchd,hnd->bchn', q[..., 0, :], peer_k1)
        s2 = jnp.einsum('bchd,hnd->bchn', q[..., 1, :], peer_k2)
        t1, i1 = lax.top_k(s1, PEER_TOPK)
        t2, i2 = lax.top_k(s2, PEER_TOPK)
        cand = (t1[..., :, None] + t2[..., None, :]).reshape(B, PEER_CHUNK, PEER_HEADS, PEER_TOPK * PEER_TOPK)
        cidx = (i1[..., :, None] * PEER_NKEYS + i2[..., None, :]).reshape(B, PEER_CHUNK, PEER_HEADS, PEER_TOPK * PEER_TOPK)
        top, pos = lax.top_k(cand, PEER_TOPK)
        eidx = jnp.take_along_axis(cidx, pos, axis=-1)
        gw = jax.nn.softmax(top.astype(jnp.float32), axis=-1).astype(hb.dtype)
        u_sel = jnp.take(peer_u, eidx, axis=0)
        act = jax.nn.gelu(jnp.einsum('bcd,bchkd->bchk', hb, u_sel))
        v_sel = jnp.take(peer_v, eidx, axis=0)
        return jnp.einsum('bchk,bchkd->bcd', gw * act, v_sel)

    out = lax.map(one_chunk, hc)
    return out.transpose(1, 0, 2, 3).reshape(B, S, D)


def encoder_layer(x, c, ada_w, ada_b, norm1_g, w_in, fnet_w, conv_w, conv_b, lru_wa, lru_ba, lru_wx, lru_bx, lru_lambda, w_out, norm2_g, peer_wq, peer_k1, peer_k2, peer_u, peer_v):
    mod = (jax.nn.silu(c) @ ada_w + ada_b)[:, None, :]
    sh1, sc1, g1, sh2, sc2, g2 = jnp.split(mod, 6, axis=-1)
    h = rmsnorm(x, norm1_g) * (1.0 + sc1) + sh1
    p = h @ w_in
    u_f = p[..., :FNET_WIDTH]
    u_x = p[..., FNET_WIDTH:FNET_WIDTH + LRU_WIDTH]
    u_g = p[..., FNET_WIDTH + LRU_WIDTH:]
    y_f = fnet_mixer(u_f, fnet_w)
    xr = centred_conv(u_x, conv_w, conv_b)
    h_l = (rglru_direction(xr, lru_wa[0], lru_ba[0], lru_wx[0], lru_bx[0], lru_lambda[0], False)
           + rglru_direction(xr, lru_wa[1], lru_ba[1], lru_wx[1], lru_bx[1], lru_lambda[1], True))
    y_l = h_l.astype(x.dtype) * jax.nn.gelu(u_g)
    o = jnp.concatenate([y_f, y_l], axis=-1) @ w_out
    x = x + g1 * o
    h2 = rmsnorm(x, norm2_g) * (1.0 + sc2) + sh2
    x = x + g2 * peer_ffn(h2, peer_wq, peer_k1, peer_k2, peer_u, peer_v)
    return x


def encode(x, c, layer_params, norm_f_g):
    for l in range(DEPTH):
        x = encoder_layer(x, c, *[p_arr[l] for p_arr in layer_params])
    return rmsnorm(x, norm_f_g)


def setup_inputs(seed: int = 0) -> dict:
    key = jax.random.key(seed)
    ks = jax.random.split(key, 32)
    f32 = jnp.float32
    D = D_MODEL
    nrm = lambda k, shape, s: jax.random.normal(k, shape, f32) * s
    p_a = jax.random.uniform(ks[14], (DEPTH, 2, LRU_WIDTH), f32, minval=0.9, maxval=0.999)
    s_a = p_a ** (1.0 / RGLRU_C)
    lru_lambda = jnp.log(s_a) - jnp.log1p(-s_a)
    return {
        "x_prompt": nrm(ks[0], (BATCH, SEQ, D), 1.0),
        "x_sample": nrm(ks[1], (DEC_BATCH, DEC_SEQ, D), 1.0),
        "c_prompt": nrm(ks[2], (BATCH, D), 1.0),
        "c_sample": nrm(ks[3], (DEC_BATCH, D), 1.0),
        "ada_w": nrm(ks[4], (DEPTH, D, 6 * D), 0.5 * D ** -0.5),
        "ada_b": nrm(ks[5], (DEPTH, 6 * D), 0.01),
        "norm1_g": 1.0 + nrm(ks[6], (DEPTH, D), 0.02),
        "w_in": nrm(ks[7], (DEPTH, D, IN_WIDTH), D ** -0.5),
        "fnet_w": nrm(ks[8], (DEPTH, FNET_GROUPS, FNET_GROUP_DIM, FNET_GROUP_DIM), FNET_GROUP_DIM ** -0.5),
        "conv_w": nrm(ks[9], (DEPTH, CONV_WIDTH, LRU_WIDTH), CONV_WIDTH ** -0.5),
        "conv_b": nrm(ks[10], (DEPTH, LRU_WIDTH), 0.01),
        "lru_wa": nrm(ks[11], (DEPTH, 2, LRU_HEADS, LRU_HEAD_DIM, LRU_HEAD_DIM), LRU_HEAD_DIM ** -0.5),
        "lru_ba": nrm(ks[12], (DEPTH, 2, LRU_HEADS, LRU_HEAD_DIM), 0.01),
        "lru_wx": nrm(ks[13], (DEPTH, 2, LRU_HEADS, LRU_HEAD_DIM, LRU_HEAD_DIM), LRU_HEAD_DIM ** -0.5),
        "lru_bx": nrm(ks[15], (DEPTH, 2, LRU_HEADS, LRU_HEAD_DIM), 0.01),
        "lru_lambda": lru_lambda,
        "w_out": nrm(ks[16], (DEPTH, MIX_WIDTH, D), MIX_WIDTH ** -0.5),
        "norm2_g": 1.0 + nrm(ks[17], (DEPTH, D), 0.02),
        "peer_wq": nrm(ks[18], (DEPTH, D, PEER_HEADS * 2 * PEER_KEY_DIM), D ** -0.5),
        "peer_k1": nrm(ks[19], (DEPTH, PEER_HEADS, PEER_NKEYS, PEER_KEY_DIM), PEER_KEY_DIM ** -0.5),
        "peer_k2": nrm(ks[20], (DEPTH, PEER_HEADS, PEER_NKEYS, PEER_KEY_DIM), PEER_KEY_DIM ** -0.5),
        "peer_u": nrm(ks[21], (DEPTH, PEER_EXPERTS, D), D ** -0.5),
        "peer_v": nrm(ks[22], (DEPTH, PEER_EXPERTS, D), 0.1),
        "norm_f_g": 1.0 + nrm(ks[23], (D,), 0.02),
    }


def reference(x_prompt, x_sample, c_prompt, c_sample, ada_w, ada_b, norm1_g, w_in, fnet_w, conv_w, conv_b, lru_wa, lru_ba, lru_wx, lru_bx, lru_lambda, w_out, norm2_g, peer_wq, peer_k1, peer_k2, peer_u, peer_v, norm_f_g):
    layer_params = (ada_w, ada_b, norm1_g, w_in, fnet_w, conv_w, conv_b, lru_wa, lru_ba, lru_wx, lru_bx, lru_lambda, w_out, norm2_g, peer_wq, peer_k1, peer_k2, peer_u, peer_v)
    y_prompt = encode(x_prompt, c_prompt, layer_params, norm_f_g)
    y_sample = encode(x_sample, c_sample, layer_params, norm_f_g)
    return (y_prompt, y_sample)
```

```cpp
#include <hip/hip_runtime.h>
#include <hip/hip_cooperative_groups.h>
#include <cstdio>
#include <cstdint>
namespace cg = cooperative_groups;

#ifndef COOP
#define COOP 1
#endif

typedef unsigned short u16;
typedef __attribute__((ext_vector_type(8))) short bf16x8;
typedef __attribute__((ext_vector_type(4))) short s16x4;
typedef __attribute__((ext_vector_type(4))) float f32x4;
typedef __attribute__((ext_vector_type(16))) float f32x16;
typedef short v4i16_t __attribute__((ext_vector_type(4)));
typedef unsigned int u32x4 __attribute__((ext_vector_type(4)));

constexpr int D = 1024;
constexpr int SEQ = 16384;
constexpr int NSEQ = 3;
constexpr int NT = NSEQ * SEQ;
constexpr int NCH = 256;
constexpr int NPHASE = 11;

constexpr size_t OFF_MOD   = 0;
constexpr size_t OFF_W1T   = 1ull << 20;
constexpr size_t OFF_W2T   = OFF_W1T + (4ull << 20);
constexpr size_t OFF_WQT   = OFF_W2T + (2ull << 20);
constexpr size_t OFF_K1B   = OFF_WQT + (4ull << 20);
constexpr size_t OFF_K2B   = OFF_K1B + (256ull << 10);
constexpr size_t OFF_WAT   = OFF_K2B + (256ull << 10);
constexpr size_t OFF_A1    = OFF_WAT + (256ull << 10);
constexpr size_t OFF_SUMP  = OFF_A1 + (256ull << 10);
constexpr size_t OFF_SUMH  = OFF_SUMP + (3ull << 20);
constexpr size_t OFF_CARRY = OFF_SUMH + (3ull << 20);
constexpr size_t OFF_MTAB  = OFF_CARRY + (3ull << 20);
constexpr size_t OFF_UB    = OFF_MTAB + (8ull << 20);
constexpr size_t OFF_VB    = OFF_UB + (32ull << 20);
constexpr size_t OFF_RA    = OFF_VB + (32ull << 20);
constexpr size_t OFF_RB    = OFF_RA + (96ull << 20);
constexpr size_t OFF_RC    = OFF_RB + (96ull << 20);
constexpr size_t WS_TOTAL  = OFF_RC + (192ull << 20);

struct Params {
  const float* x_prompt; const float* x_sample; const float* c_prompt; const float* c_sample;
  const float* ada_w; const float* ada_b; const float* norm1_g; const float* w_in; const float* fnet_w;
  const float* conv_w; const float* conv_b; const float* lru_wa; const float* lru_ba; const float* lru_wx;
  const float* lru_bx; const float* lru_lambda; const float* w_out; const float* norm2_g; const float* peer_wq;
  const float* peer_k1; const float* peer_k2; const float* peer_u; const float* peer_v; const float* norm_f_g;
  float* out; char* ws;
  int phase_lo; int phase_hi;
};

__device__ __forceinline__ unsigned f2bf(float f) { unsigned u = __float_as_uint(f); u += 0x7FFFu + ((u >> 16) & 1u); return u >> 16; }
__device__ __forceinline__ unsigned pack2(float a, float b) { return f2bf(a) | (f2bf(b) << 16); }
__device__ __forceinline__ float bflo(unsigned u) { return __uint_as_float(u << 16); }
__device__ __forceinline__ float bfhi(unsigned u) { return __uint_as_float(u & 0xFFFF0000u); }
__device__ __forceinline__ float sigmoidf_(float x) { return 1.f / (1.f + __expf(-x)); }
__device__ __forceinline__ float gelu_tanh(float x) {
  float y = 0.7978845608028654f * (x + 0.044715f * x * x * x);
  return x / (1.f + __expf(-2.f * y));
}
__device__ __forceinline__ float wave_sum(float v) {
#pragma unroll
  for (int o = 32; o > 0; o >>= 1) v += __shfl_xor(v, o);
  return v;
}
__device__ __forceinline__ const float* xrow(const Params& p, int T) {
  return (T < 2 * SEQ) ? p.x_prompt + (size_t)T * D : p.x_sample + (size_t)(T - 2 * SEQ) * D;
}

constexpr int BK = 64;
constexpr int LDSA = BK + 8;
constexpr int LDSB_NN = 128 + 8;
constexpr int SMEM_GEMM = 2 * 128 * LDSA * 2;

template <int BMODE, class ARow, class BRow, class Epi>
__device__ __forceinline__ void gemm_tile(ARow arow, BRow brow, int K, Epi epi, char* smem) {
  u16* sA = (u16*)smem;
  u16* sB = sA + 128 * LDSA;
  const int tid = threadIdx.x, lane = tid & 63, w = tid >> 6;
  const int wm = w >> 1, wn = w & 1;
  f32x4 acc[4][4];
#pragma unroll
  for (int i = 0; i < 4; ++i)
#pragma unroll
    for (int j = 0; j < 4; ++j) acc[i][j] = (f32x4){0.f, 0.f, 0.f, 0.f};

  const u16* pa[4];
  const u16* pb[4];
#pragma unroll
  for (int i = 0; i < 4; ++i) {
    int c = tid + 256 * i;
    pa[i] = arow(c >> 3) + (c & 7) * 8;
    if (BMODE == 0) pb[i] = brow(c >> 3) + (c & 7) * 8;
  }
  u32x4 ra[4], rb[4];
#define GLOAD(k0_)                                                                                       \
  _Pragma("unroll") for (int i = 0; i < 4; ++i) {                                                        \
    ra[i] = *(const u32x4*)(pa[i] + (k0_));                                                              \
    if (BMODE == 0) rb[i] = *(const u32x4*)(pb[i] + (k0_));                                              \
    else { int c = tid + 256 * i; rb[i] = *(const u32x4*)(brow((k0_) + (c >> 4)) + (c & 15) * 8); }      \
  }
  GLOAD(0)
  for (int k0 = 0; k0 < K; k0 += BK) {
    __syncthreads();
#pragma unroll
    for (int i = 0; i < 4; ++i) {
      int c = tid + 256 * i;
      *(u32x4*)(sA + (c >> 3) * LDSA + (c & 7) * 8) = ra[i];
      if (BMODE == 0) *(u32x4*)(sB + (c >> 3) * LDSA + (c & 7) * 8) = rb[i];
      else *(u32x4*)(sB + (c >> 4) * LDSB_NN + (c & 15) * 8) = rb[i];
    }
    __syncthreads();
    if (k0 + BK < K) { GLOAD(k0 + BK) }
#pragma unroll
    for (int kk = 0; kk < 2; ++kk) {
      bf16x8 af[4], bfr[4];
#pragma unroll
      for (int mt = 0; mt < 4; ++mt)
        af[mt] = *(const bf16x8*)(sA + (wm * 64 + mt * 16 + (lane & 15)) * LDSA + kk * 32 + (lane >> 4) * 8);
#pragma unroll
      for (int nt = 0; nt < 4; ++nt) {
        if (BMODE == 0) {
          bfr[nt] = *(const bf16x8*)(sB + (wn * 64 + nt * 16 + (lane & 15)) * LDSA + kk * 32 + (lane >> 4) * 8);
        } else {
          int g = lane >> 4, i16 = lane & 15, q = i16 >> 2, pq = i16 & 3;
          const u16* ad = sB + (kk * 32 + 8 * g + q) * LDSB_NN + wn * 64 + nt * 16 + 4 * pq;
          v4i16_t lo = __builtin_amdgcn_ds_read_tr16_b64_v4i16((__attribute__((address_space(3))) v4i16_t*)(ad));
          v4i16_t hi = __builtin_amdgcn_ds_read_tr16_b64_v4i16((__attribute__((address_space(3))) v4i16_t*)(ad + 4 * LDSB_NN));
          bfr[nt] = (bf16x8){lo[0], lo[1], lo[2], lo[3], hi[0], hi[1], hi[2], hi[3]};
        }
      }
#pragma unroll
      for (int mt = 0; mt < 4; ++mt)
#pragma unroll
        for (int nt = 0; nt < 4; ++nt)
          acc[mt][nt] = __builtin_amdgcn_mfma_f32_16x16x32_bf16(af[mt], bfr[nt], acc[mt][nt], 0, 0, 0);
    }
  }
#pragma unroll
  for (int mt = 0; mt < 4; ++mt)
#pragma unroll
    for (int nt = 0; nt < 4; ++nt)
#pragma unroll
      for (int j = 0; j < 4; ++j)
        epi(wm * 64 + mt * 16 + (lane >> 4) * 4 + j, wn * 64 + nt * 16 + (lane & 15), acc[mt][nt][j]);
}

__device__ void phase0(const Params& p, char* smem) {
  const int tid = threadIdx.x, nb = gridDim.x, bid = blockIdx.x;
  float* sf = (float*)smem;
  float* mod = (float*)(p.ws + OFF_MOD);
  for (int item = bid; item < 96; item += nb) {
    int col = item * 64 + (tid & 63), ks = tid >> 6;
    float a0 = 0.f, a1 = 0.f, a2 = 0.f;
    for (int k = ks * 256; k < ks * 256 + 256; ++k) {
      float wv = p.ada_w[(size_t)k * 6144 + col];
      float c0 = p.c_prompt[k], c1 = p.c_prompt[1024 + k], c2 = p.c_sample[k];
      a0 += c0 * sigmoidf_(c0) * wv; a1 += c1 * sigmoidf_(c1) * wv; a2 += c2 * sigmoidf_(c2) * wv;
    }
    __syncthreads();
    sf[tid * 3 + 0] = a0; sf[tid * 3 + 1] = a1; sf[tid * 3 + 2] = a2;
    __syncthreads();
    if (tid < 64) {
      float bsum = p.ada_b[col];
#pragma unroll
      for (int s = 0; s < 3; ++s) {
        float v = sf[tid * 3 + s] + sf[(tid + 64) * 3 + s] + sf[(tid + 128) * 3 + s] + sf[(tid + 192) * 3 + s];
        mod[s * 6144 + col] = v + bsum;
      }
    }
  }
  __syncthreads();
  float* ct = sf + 1024; float* st = sf + 1024 + 64;
  if (tid < 64) { ct[tid] = cospif(tid / 32.f); st[tid] = sinpif(tid / 32.f); }
  __syncthreads();
  const size_t gtid = (size_t)bid * 256 + tid, gstride = (size_t)nb * 256;
  {
    u16* w1T = (u16*)(p.ws + OFF_W1T);
    for (size_t idx = gtid; idx < 2048ull * 1024; idx += gstride) {
      int n = (int)(idx >> 10), k = (int)(idx & 1023);
      float v;
      if (n < 1024) {
        int comp = n >> 9, g = (n >> 6) & 7, kk = n & 63;
        const float* src = p.w_in + (size_t)k * 1536 + g * 64;
        float s = 0.f;
        for (int c = 0; c < 64; ++c) {
          int j = (c * kk) & 63;
          float tw = comp ? -st[j] : ct[j];
          s += src[c] * tw;
        }
        v = s;
      } else {
        v = p.w_in[(size_t)k * 1536 + (n - 512)];
      }
      w1T[idx] = (u16)f2bf(v);
    }
  }
  {
    u16* w2T = (u16*)(p.ws + OFF_W2T);
    for (size_t idx = gtid; idx < 1024ull * 1024; idx += gstride) {
      int n = (int)(idx >> 10), k = (int)(idx & 1023);
      float v;
      if (k < 512) {
        int g = k >> 6;
        const float* fw = p.fnet_w + (size_t)k * 64;
        const float* wo = p.w_out + (size_t)(g * 64) * 1024 + n;
        float s = 0.f;
        for (int d = 0; d < 64; ++d) s += fw[d] * wo[(size_t)d * 1024];
        v = s * (1.f / 1024.f);
      } else {
        v = p.w_out[(size_t)k * 1024 + n];
      }
      w2T[idx] = (u16)f2bf(v);
    }
  }
  {
    u16* wqT = (u16*)(p.ws + OFF_WQT);
    for (size_t idx = gtid; idx < 2048ull * 1024; idx += gstride) {
      int n = (int)(idx >> 10), k = (int)(idx & 1023);
      wqT[idx] = (u16)f2bf(p.peer_wq[(size_t)k * 2048 + n]);
    }
  }
  {
    u16* k1b = (u16*)(p.ws + OFF_K1B); u16* k2b = (u16*)(p.ws + OFF_K2B);
    for (size_t idx = gtid; idx < 131072; idx += gstride) { k1b[idx] = (u16)f2bf(p.peer_k1[idx]); k2b[idx] = (u16)f2bf(p.peer_k2[idx]); }
  }
  {
    u16* waT = (u16*)(p.ws + OFF_WAT);
    for (size_t idx = gtid; idx < 131072; idx += gstride) {
      int i = idx & 63, j = (idx >> 6) & 63, h = (idx >> 12) & 7, gate = (idx >> 15) & 1, d = (int)(idx >> 16);
      const float* src = gate ? p.lru_wx : p.lru_wa;
      waT[idx] = (u16)f2bf(src[((size_t)(d * 8 + h) * 64 + i) * 64 + j]);
    }
  }
  {
    u16* A1 = (u16*)(p.ws + OFF_A1);
    for (size_t idx = gtid; idx < 65536; idx += gstride) {
      int m = (int)(idx >> 8), k = (int)(idx & 255);
      int cp = m >> 7, k1 = m & 127, comp = k >> 7, s1 = k & 127;
      int j = (k1 * s1) & 127;
      float C = cospif(j / 64.f), S = sinpif(j / 64.f);
      float v = (cp == comp) ? C : (cp == 0 ? S : -S);
      A1[idx] = (u16)f2bf(v);
    }
    u16* Mt = (u16*)(p.ws + OFF_MTAB);
    for (size_t idx = gtid; idx < 128ull * 128 * 256; idx += gstride) {
      int k = (int)(idx & 255), k2 = (int)((idx >> 8) & 127), k1 = (int)(idx >> 15);
      int comp = k >> 7, s2 = k & 127;
      int j = (s2 * (k1 + 128 * k2)) & 16383;
      float v = comp ? sinpif(j / 8192.f) : cospif(j / 8192.f);
      Mt[idx] = (u16)f2bf(v);
    }
  }
  {
    uint2* ub = (uint2*)(p.ws + OFF_UB); uint2* vb = (uint2*)(p.ws + OFF_VB);
    const float4* us = (const float4*)p.peer_u; const float4* vs = (const float4*)p.peer_v;
    for (size_t idx = gtid; idx < 16384ull * 256; idx += gstride) {
      float4 a = us[idx]; ub[idx] = make_uint2(pack2(a.x, a.y), pack2(a.z, a.w));
      float4 b = vs[idx]; vb[idx] = make_uint2(pack2(b.x, b.y), pack2(b.z, b.w));
    }
  }
}

template <bool SECOND>
__device__ void phase_norm(const Params& p) {
  const int lane = threadIdx.x & 63;
  const int gw = blockIdx.x * 4 + (threadIdx.x >> 6), nw = gridDim.x * 4;
  const float* mod = (const float*)(p.ws + OFF_MOD);
  const float* gain = SECOND ? p.norm2_g : p.norm1_g;
  u16* dst = (u16*)(p.ws + OFF_RA);
  for (int T = gw; T < NT; T += nw) {
    const float* xr = SECOND ? (p.out + (size_t)T * D) : xrow(p, T);
    const int seq = T >> 14;
    const float* sh = mod + seq * 6144 + (SECOND ? 3072 : 0);
    const float* sc = mod + seq * 6144 + (SECOND ? 4096 : 1024);
    float4 v[4]; float ss = 0.f;
#pragma unroll
    for (int i = 0; i < 4; ++i) {
      v[i] = ((const float4*)xr)[lane + 64 * i];
      ss += v[i].x * v[i].x + v[i].y * v[i].y + v[i].z * v[i].z + v[i].w * v[i].w;
    }
    ss = wave_sum(ss);
    float rstd = rsqrtf(ss * (1.f / 1024.f) + 1e-6f);
#pragma unroll
    for (int i = 0; i < 4; ++i) {
      int col = 4 * (lane + 64 * i);
      float4 g = *(const float4*)(gain + col), s1 = *(const float4*)(sc + col), s0 = *(const float4*)(sh + col);
      float y0 = v[i].x * rstd * g.x * (1.f + s1.x) + s0.x;
      float y1 = v[i].y * rstd * g.y * (1.f + s1.y) + s0.y;
      float y2 = v[i].z * rstd * g.z * (1.f + s1.z) + s0.z;
      float y3 = v[i].w * rstd * g.w * (1.f + s1.w) + s0.w;
      *(uint2*)(dst + (size_t)T * D + col) = make_uint2(pack2(y0, y1), pack2(y2, y3));
    }
  }
}

__device__ void phase_gemm1(const Params& p, char* smem) {
  const u16* h1 = (const u16*)(p.ws + OFF_RA);
  const u16* w1T = (const u16*)(p.ws + OFF_W1T);
  u16* Z = (u16*)(p.ws + OFF_RB);
  u16* ux = (u16*)(p.ws + OFF_RC);
  u16* gg = ux + (size_t)NT * 512;
  for (int tile = blockIdx.x; tile < 384 * 16; tile += gridDim.x) {
    const int mt = tile >> 4, nt = tile & 15;
    const int T0 = mt * 128, n0 = nt * 128;
    auto arow = [&](int r) { return h1 + (size_t)(T0 + r) * D; };
    auto brow = [&](int r) { return w1T + (size_t)(n0 + r) * D; };
    if (nt < 8) {
      gemm_tile<0>(arow, brow, D, [&](int r, int c, float v) { Z[(size_t)(T0 + r) * 1024 + n0 + c] = (u16)f2bf(v); }, smem);
    } else if (nt < 12) {
      gemm_tile<0>(arow, brow, D, [&](int r, int c, float v) { ux[(size_t)(T0 + r) * 512 + (n0 - 1024) + c] = (u16)f2bf(v); }, smem);
    } else {
      gemm_tile<0>(arow, brow, D, [&](int r, int c, float v) { gg[(size_t)(T0 + r) * 512 + (n0 - 1536) + c] = (u16)f2bf(gelu_tanh(v)); }, smem);
    }
  }
}

__device__ void phase_fft1(const Params& p, char* smem) {
  const u16* Z = (const u16*)(p.ws + OFF_RB);
  const u16* A1 = (const u16*)(p.ws + OFF_A1);
  u16* Tb = (u16*)(p.ws + OFF_RA);
  for (int tile = blockIdx.x; tile < 3072; tile += gridDim.x) {
    const int mtile = tile & 1, chb = (tile >> 1) & 3, s2 = (tile >> 3) & 127, b = tile >> 10;
    const u16* Zb = Z + ((size_t)b * SEQ + s2) * 1024 + chb * 128;
    auto arow = [&](int r) { return A1 + (size_t)(mtile * 128 + r) * 256; };
    auto brow = [&](int k) { return Zb + (size_t)(k & 127) * (128 * 1024) + (k >> 7) * 512; };
    u16* To = Tb + (((size_t)b * 128) * 128 + s2) * 1024 + mtile * 512 + chb * 128;
    gemm_tile<1>(arow, brow, 256, [&](int r, int c, float v) { To[(size_t)r * (128 * 1024) + c] = (u16)f2bf(v); }, smem);
  }
}

constexpr int XP = 68;
constexpr int SMEM_LRU = 64 * XP * 4 + 2 * 64 * 64 * 4;
__device__ void phase_lru_local(const Params& p, char* smem) {
  float* sX = (float*)smem;
  float* sAa = sX + 64 * XP;
  float* sBb = sAa + 64 * 64;
  u16* stg = (u16*)sAa;
  const int tid = threadIdx.x, lane = tid & 63, w = tid >> 6;
  const u16* ux = (const u16*)(p.ws + OFF_RC);
  const u16* waT = (const u16*)(p.ws + OFF_WAT);
  float* sumP = (float*)(p.ws + OFF_SUMP);
  float* sumH = (float*)(p.ws + OFF_SUMH);
  u16* HP = (u16*)p.out;
  for (int tile = blockIdx.x; tile < NSEQ * NCH * 8; tile += gridDim.x) {
    const int h = tile & 7, c = (tile >> 3) & (NCH - 1), b = tile >> 11;
    const int T0 = b * SEQ + c * 64;
    __syncthreads();
    for (int idx = tid; idx < 67 * 8; idx += 256) {
      int r = idx >> 3, c8 = idx & 7;
      int t = c * 64 - 2 + r;
      uint4 v = make_uint4(0, 0, 0, 0);
      if (t >= 0 && t < SEQ) v = *(const uint4*)(ux + ((size_t)b * SEQ + t) * 512 + h * 64 + c8 * 8);
      *(uint4*)(stg + r * 64 + c8 * 8) = v;
    }
    __syncthreads();
    {
      const int ch = tid & 63, chg = h * 64 + ch;
      const float w0 = p.conv_w[chg], w1 = p.conv_w[512 + chg], w2 = p.conv_w[1024 + chg], w3 = p.conv_w[1536 + chg];
      const float cb = p.conv_b[chg];
#pragma unroll 4
      for (int i = 0; i < 16; ++i) {
        int t = (tid >> 6) + 4 * i;
        float v = cb + w0 * __uint_as_float((unsigned)stg[t * 64 + ch] << 16) + w1 * __uint_as_float((unsigned)stg[(t + 1) * 64 + ch] << 16)
                + w2 * __uint_as_float((unsigned)stg[(t + 2) * 64 + ch] << 16) + w3 * __uint_as_float((unsigned)stg[(t + 3) * 64 + ch] << 16);
        sX[t * XP + ch] = v;
      }
    }
    __syncthreads();
    bf16x8 af[2];
#pragma unroll
    for (int kk = 0; kk < 2; ++kk) {
      const float* src = sX + (16 * w + (lane & 15)) * XP + kk * 32 + (lane >> 4) * 8;
      float4 f0 = *(const float4*)src, f1 = *(const float4*)(src + 4);
      af[kk] = (bf16x8){(short)f2bf(f0.x), (short)f2bf(f0.y), (short)f2bf(f0.z), (short)f2bf(f0.w),
                        (short)f2bf(f1.x), (short)f2bf(f1.y), (short)f2bf(f1.z), (short)f2bf(f1.w)};
    }
    for (int d = 0; d < 2; ++d) {
      f32x4 acc[2][4];
#pragma unroll
      for (int g = 0; g < 2; ++g)
#pragma unroll
        for (int nt = 0; nt < 4; ++nt) {
          acc[g][nt] = (f32x4){0.f, 0.f, 0.f, 0.f};
#pragma unroll
          for (int kk = 0; kk < 2; ++kk) {
            const u16* bp = waT + ((size_t)((d * 2 + g) * 8 + h) * 64 + nt * 16 + (lane & 15)) * 64 + kk * 32 + (lane >> 4) * 8;
            bf16x8 bfr = *(const bf16x8*)bp;
            acc[g][nt] = __builtin_amdgcn_mfma_f32_16x16x32_bf16(af[kk], bfr, acc[g][nt], 0, 0, 0);
          }
        }
#pragma unroll
      for (int nt = 0; nt < 4; ++nt) {
        const int ch = nt * 16 + (lane & 15), chg = h * 64 + ch;
        const float ba = p.lru_ba[d * 512 + chg], bx = p.lru_bx[d * 512 + chg];
        const float lam = p.lru_lambda[d * 512 + chg];
        const float cl = -8.f * log1pf(expf(-lam));
#pragma unroll
        for (int j = 0; j < 4; ++j) {
          const int tok = 16 * w + 4 * (lane >> 4) + j;
          float r = sigmoidf_(acc[0][nt][j] + ba);
          float ii = sigmoidf_(acc[1][nt][j] + bx);
          float la = cl * r;
          float a = expf(la);
          float bb = sqrtf(-expm1f(2.f * la)) * ii * sX[tok * XP + ch];
          sAa[tok * 64 + ch] = a; sBb[tok * 64 + ch] = bb;
        }
      }
      __syncthreads();
      if (tid < 64) {
        const int ch = tid;
        float hh = 0.f, P = 1.f;
        if (d == 0) {
          for (int t = 0; t < 64; ++t) {
            float a = sAa[t * 64 + ch], bb = sBb[t * 64 + ch];
            hh = a * hh + bb; P *= a;
            sBb[t * 64 + ch] = hh; sAa[t * 64 + ch] = P;
          }
        } else {
          for (int t = 63; t >= 0; --t) {
            float a = sAa[t * 64 + ch], bb = sBb[t * 64 + ch];
            hh = a * hh + bb; P *= a;
            sBb[t * 64 + ch] = hh; sAa[t * 64 + ch] = P;
          }
        }
        size_t si = ((size_t)(b * NCH + c) * 2 + d) * 512 + h * 64 + ch;
        sumP[si] = P; sumH[si] = hh;
      }
      __syncthreads();
      u16* Hd = HP + (size_t)(d * 2 + 0) * NT * 512;
      u16* Pd = HP + (size_t)(d * 2 + 1) * NT * 512;
#pragma unroll
      for (int i = 0; i < 2; ++i) {
        int idx = tid + 256 * i; int t = idx >> 3, c8 = idx & 7;
        const float* hs = sBb + t * 64 + c8 * 8; const float* ps = sAa + t * 64 + c8 * 8;
        size_t o = (size_t)(T0 + t) * 512 + h * 64 + c8 * 8;
        *(uint4*)(Hd + o) = make_uint4(pack2(hs[0], hs[1]), pack2(hs[2], hs[3]), pack2(hs[4], hs[5]), pack2(hs[6], hs[7]));
        *(uint4*)(Pd + o) = make_uint4(pack2(ps[0], ps[1]), pack2(ps[2], ps[3]), pack2(ps[4], ps[5]), pack2(ps[6], ps[7]));
      }
      __syncthreads();
    }
  }
}

__device__ void phase_carry(const Params& p) {
  const float* sumP = (const float*)(p.ws + OFF_SUMP);
  const float* sumH = (const float*)(p.ws + OFF_SUMH);
  float* carry = (float*)(p.ws + OFF_CARRY);
  const int gid = blockIdx.x * 256 + threadIdx.x;
  if (gid >= NSEQ * 2 * 512) return;
  const int chg = gid & 511, d = (gid >> 9) & 1, b = gid >> 10;
  float cin = 0.f;
  if (d == 0) {
#pragma unroll 4
    for (int c = 0; c < NCH; ++c) {
      size_t si = ((size_t)(b * NCH + c) * 2 + d) * 512 + chg;
      float P = sumP[si], H = sumH[si];
      carry[si] = cin; cin = P * cin + H;
    }
  } else {
#pragma unroll 4
    for (int c = NCH - 1; c >= 0; --c) {
      size_t si = ((size_t)(b * NCH + c) * 2 + d) * 512 + chg;
      float P = sumP[si], H = sumH[si];
      carry[si] = cin; cin = P * cin + H;
    }
  }
}

__device__ void phase_fft3(const Params& p, char* smem) {
  const u16* Tb = (const u16*)(p.ws + OFF_RA);
  const u16* Mt = (const u16*)(p.ws + OFF_MTAB);
  u16* Y = (u16*)(p.ws + OFF_RB);
  for (int tile = blockIdx.x; tile < 1536; tile += gridDim.x) {
    const int chb = tile & 3, k1 = (tile >> 2) & 127, b = tile >> 9;
    const u16* Tk = Tb + ((size_t)(b * 128 + k1) * 128) * 1024 + chb * 128;
    auto arow = [&](int r) { return Mt + ((size_t)k1 * 128 + r) * 256; };
    auto brow = [&](int k) { return Tk + (size_t)(k & 127) * 1024 + (k >> 7) * 512; };
    u16* Yo = Y + ((size_t)b * SEQ + k1) * 1024 + chb * 128;
    gemm_tile<1>(arow, brow, 256, [&](int r, int c, float v) { Yo[(size_t)r * (128 * 1024) + c] = (u16)f2bf(v); }, smem);
  }
}

__device__ void phase_lru_fix(const Params& p) {
  const u16* HP = (const u16*)p.out;
  const u16* gg = (const u16*)(p.ws + OFF_RC) + (size_t)NT * 512;
  const float* carry = (const float*)(p.ws + OFF_CARRY);
  u16* Y = (u16*)(p.ws + OFF_RB);
  const size_t gtid = (size_t)blockIdx.x * 256 + threadIdx.x, gstride = (size_t)gridDim.x * 256;
  for (size_t idx = gtid; idx < (size_t)NT * 64; idx += gstride) {
    const int T = (int)(idx >> 6), ch0 = (int)(idx & 63) * 8;
    const int b = T >> 14, c = (T & (SEQ - 1)) >> 6;
    const size_t o = (size_t)T * 512 + ch0;
    uint4 hf = *(const uint4*)(HP + o), pf = *(const uint4*)(HP + (size_t)NT * 512 + o);
    uint4 hr = *(const uint4*)(HP + (size_t)2 * NT * 512 + o), pr = *(const uint4*)(HP + (size_t)3 * NT * 512 + o);
    uint4 g = *(const uint4*)(gg + o);
    const float* cf = carry + ((size_t)(b * NCH + c) * 2 + 0) * 512 + ch0;
    const float* cr = carry + ((size_t)(b * NCH + c) * 2 + 1) * 512 + ch0;
    float4 cf0 = *(const float4*)cf, cf1 = *(const float4*)(cf + 4), cr0 = *(const float4*)cr, cr1 = *(const float4*)(cr + 4);
    float y0 = (bflo(hf.x) + bflo(pf.x) * cf0.x + bflo(hr.x) + bflo(pr.x) * cr0.x) * bflo(g.x);
    float y1 = (bfhi(hf.x) + bfhi(pf.x) * cf0.y + bfhi(hr.x) + bfhi(pr.x) * cr0.y) * bfhi(g.x);
    float y2 = (bflo(hf.y) + bflo(pf.y) * cf0.z + bflo(hr.y) + bflo(pr.y) * cr0.z) * bflo(g.y);
    float y3 = (bfhi(hf.y) + bfhi(pf.y) * cf0.w + bfhi(hr.y) + bfhi(pr.y) * cr0.w) * bfhi(g.y);
    float y4 = (bflo(hf.z) + bflo(pf.z) * cf1.x + bflo(hr.z) + bflo(pr.z) * cr1.x) * bflo(g.z);
    float y5 = (bfhi(hf.z) + bfhi(pf.z) * cf1.y + bfhi(hr.z) + bfhi(pr.z) * cr1.y) * bfhi(g.z);
    float y6 = (bflo(hf.w) + bflo(pf.w) * cf1.z + bflo(hr.w) + bflo(pr.w) * cr1.z) * bflo(g.w);
    float y7 = (bfhi(hf.w) + bfhi(pf.w) * cf1.w + bfhi(hr.w) + bfhi(pr.w) * cr1.w) * bfhi(g.w);
    *(uint4*)(Y + (size_t)T * 1024 + 512 + ch0) = make_uint4(pack2(y0, y1), pack2(y2, y3), pack2(y4, y5), pack2(y6, y7));
  }
}

__device__ void phase_gemm2(const Params& p, char* smem) {
  const u16* Y = (const u16*)(p.ws + OFF_RB);
  const u16* w2T = (const u16*)(p.ws + OFF_W2T);
  const float* mod = (const float*)(p.ws + OFF_MOD);
  for (int tile = blockIdx.x; tile < 384 * 8; tile += gridDim.x) {
    const int mt = tile >> 3, nt = tile & 7;
    const int T0 = mt * 128, n0 = nt * 128;
    const int seq = T0 >> 14;
    const float* g1 = mod + seq * 6144 + 2048 + n0;
    auto arow = [&](int r) { return Y + (size_t)(T0 + r) * D; };
    auto brow = [&](int r) { return w2T + (size_t)(n0 + r) * D; };
    gemm_tile<0>(arow, brow, D, [&](int r, int c, float v) {
      const float* xr = xrow(p, T0 + r);
      p.out[(size_t)(T0 + r) * D + n0 + c] = xr[n0 + c] + g1[c] * v;
    }, smem);
  }
}

__device__ void phase_gemm3(const Params& p, char* smem) {
  const u16* h2 = (const u16*)(p.ws + OFF_RA);
  const u16* wqT = (const u16*)(p.ws + OFF_WQT);
  u16* q = (u16*)(p.ws + OFF_RC);
  for (int tile = blockIdx.x; tile < 384 * 16; tile += gridDim.x) {
    const int mt = tile >> 4, nt = tile & 15;
    const int T0 = mt * 128, n0 = nt * 128;
    auto arow = [&](int r) { return h2 + (size_t)(T0 + r) * D; };
    auto brow = [&](int r) { return wqT + (size_t)(n0 + r) * D; };
    gemm_tile<0>(arow, brow, D, [&](int r, int c, float v) { q[(size_t)(T0 + r) * 2048 + n0 + c] = (u16)f2bf(v); }, smem);
  }
}

template <int N>
__device__ __forceinline__ void bitonic_sort_desc(float (&v)[N]) {
#pragma unroll
  for (int k = 2; k <= N; k <<= 1) {
#pragma unroll
    for (int j = k >> 1; j > 0; j >>= 1) {
#pragma unroll
      for (int i = 0; i < N; ++i) {
        const int l = i ^ j;
        if (l > i) {
          const bool desc = ((i & k) == 0);
          float mx = fmaxf(v[i], v[l]), mn = fminf(v[i], v[l]);
          v[i] = desc ? mx : mn; v[l] = desc ? mn : mx;
        }
      }
    }
  }
}
template <int N>
__device__ __forceinline__ void bitonic_merge_desc(float (&v)[N]) {
#pragma unroll
  for (int j = N >> 1; j > 0; j >>= 1) {
#pragma unroll
    for (int i = 0; i < N; ++i) {
      const int l = i ^ j;
      if (l > i) { float mx = fmaxf(v[i], v[l]), mn = fminf(v[i], v[l]); v[i] = mx; v[l] = mn; }
    }
  }
}
__device__ __forceinline__ void top16_of_64(const float (&v)[64], float (&top)[16]) {
#pragma unroll
  for (int i = 0; i < 16; ++i) top[i] = v[i];
  bitonic_sort_desc<16>(top);
#pragma unroll
  for (int g = 1; g < 4; ++g) {
    float blk[16];
#pragma unroll
    for (int i = 0; i < 16; ++i) blk[i] = v[16 * g + i];
    bitonic_sort_desc<16>(blk);
#pragma unroll
    for (int i = 0; i < 16; ++i) top[i] = fmaxf(top[i], blk[15 - i]);
    bitonic_merge_desc<16>(top);
  }
}

__device__ __forceinline__ void score_top16(const u16* __restrict__ kb, const u16* __restrict__ qp, int lane, float (&top)[16]) {
  f32x16 acc[4];
#pragma unroll
  for (int mt = 0; mt < 4; ++mt)
#pragma unroll
    for (int r = 0; r < 16; ++r) acc[mt][r] = 0.f;
#pragma unroll 2
  for (int ks = 0; ks < 8; ++ks) {
    bf16x8 bq = *(const bf16x8*)(qp + ks * 16);
#pragma unroll
    for (int mt = 0; mt < 4; ++mt) {
      bf16x8 ak = *(const bf16x8*)(kb + (size_t)(mt * 32 + (lane & 31)) * 128 + ks * 16 + (lane >> 5) * 8);
      acc[mt] = __builtin_amdgcn_mfma_f32_32x32x16_bf16(ak, bq, acc[mt], 0, 0, 0);
    }
  }
  float v[64];
  const int hi = lane >> 5;
#pragma unroll
  for (int mt = 0; mt < 4; ++mt)
#pragma unroll
    for (int r = 0; r < 16; ++r) {
      const unsigned key = 32 * mt + (r & 3) + 8 * (r >> 2) + 4 * hi;
      v[mt * 16 + r] = __uint_as_float((__float_as_uint(acc[mt][r]) & ~127u) | key);
    }
  top16_of_64(v, top);
  float t[16];
#pragma unroll
  for (int i = 0; i < 16; ++i) t[i] = __shfl_xor(top[i], 32);
#pragma unroll
  for (int i = 0; i < 16; ++i) top[i] = fmaxf(top[i], t[15 - i]);
  bitonic_merge_desc<16>(top);
}

__device__ void phase_topk(const Params& p) {
  const int lane = threadIdx.x & 63;
  const int gw = blockIdx.x * 4 + (threadIdx.x >> 6), nw = gridDim.x * 4;
  const u16* q = (const u16*)(p.ws + OFF_RC);
  const u16* k1b = (const u16*)(p.ws + OFF_K1B);
  const u16* k2b = (const u16*)(p.ws + OFF_K2B);
  uint4* eg = (uint4*)(p.ws + OFF_RB);
  for (int item = gw; item < (NT / 32) * 8; item += nw) {
    const int h = item & 7, grp = item >> 3;
    const int T = grp * 32 + (lane & 31);
    const u16* qp = q + (size_t)T * 2048 + h * 256 + (lane >> 5) * 8;
    float t1[16], t2[16];
    score_top16(k1b + (size_t)h * 16384, qp, lane, t1);
    score_top16(k2b + (size_t)h * 16384, qp + 128, lane, t2);
    float cand[64];
#pragma unroll
    for (int i = 0; i < 64; ++i) cand[i] = -3.0e38f;
    {
      int n = 0;
#pragma unroll
      for (int a = 0; a < 16; ++a) {
#pragma unroll
        for (int bb = 0; bb < 16; ++bb) {
          if ((a + 1) * (bb + 1) <= 16) {
            unsigned ia = __float_as_uint(t1[a]) & 127u, ib = __float_as_uint(t2[bb]) & 127u;
            float s = t1[a] + t2[bb];
            cand[n] = __uint_as_float((__float_as_uint(s) & ~16383u) | (ia << 7) | ib);
            ++n;
          }
        }
      }
    }
    float top[16];
    top16_of_64(cand, top);
    float wgt[16]; float mx, sum = 0.f;
    mx = __uint_as_float(__float_as_uint(top[0]) & ~16383u);
#pragma unroll
    for (int i = 0; i < 16; ++i) { wgt[i] = __expf(__uint_as_float(__float_as_uint(top[i]) & ~16383u) - mx); sum += wgt[i]; }
    const float inv = 1.f / sum;
    if (lane < 32) {
      uint4* dst = eg + ((size_t)T * 8 + h) * 8;
#pragma unroll
      for (int i = 0; i < 8; ++i) {
        dst[i] = make_uint4(__float_as_uint(top[2 * i]) & 16383u, __float_as_uint(wgt[2 * i] * inv),
                            __float_as_uint(top[2 * i + 1]) & 16383u, __float_as_uint(wgt[2 * i + 1] * inv));
      }
    }
  }
}

__device__ void phase_peer(const Params& p) {
  const int lane = threadIdx.x & 63;
  const int gw = blockIdx.x * 4 + (threadIdx.x >> 6), nw = gridDim.x * 4;
  const u16* h2 = (const u16*)(p.ws + OFF_RA);
  const u16* ub = (const u16*)(p.ws + OFF_UB);
  const u16* vb = (const u16*)(p.ws + OFF_VB);
  const uint2* eg = (const uint2*)(p.ws + OFF_RB);
  const float* mod = (const float*)(p.ws + OFF_MOD);
  for (int T = gw; T < NT; T += nw) {
    const int seq = T >> 14;
    float hf[16];
    {
      uint4 ha = *(const uint4*)(h2 + (size_t)T * D + lane * 8), hb = *(const uint4*)(h2 + (size_t)T * D + 512 + lane * 8);
      hf[0] = bflo(ha.x); hf[1] = bfhi(ha.x); hf[2] = bflo(ha.y); hf[3] = bfhi(ha.y);
      hf[4] = bflo(ha.z); hf[5] = bfhi(ha.z); hf[6] = bflo(ha.w); hf[7] = bfhi(ha.w);
      hf[8] = bflo(hb.x); hf[9] = bfhi(hb.x); hf[10] = bflo(hb.y); hf[11] = bfhi(hb.y);
      hf[12] = bflo(hb.z); hf[13] = bfhi(hb.z); hf[14] = bflo(hb.w); hf[15] = bfhi(hb.w);
    }
    float o[16];
#pragma unroll
    for (int i = 0; i < 16; ++i) o[i] = 0.f;
    for (int h = 0; h < 8; ++h) {
      uint2 e2 = eg[((size_t)T * 8 + h) * 16 + (lane & 15)];
      const int ereg = (int)e2.x;
      const float greg = __uint_as_float(e2.y);
      float acc[16];
#pragma unroll
      for (int k = 0; k < 16; ++k) {
        const int e = __builtin_amdgcn_readlane(ereg, k);
        const u16* ur = ub + (size_t)e * D;
        uint4 a = *(const uint4*)(ur + lane * 8), b = *(const uint4*)(ur + 512 + lane * 8);
        float s = hf[0] * bflo(a.x);
        s += hf[1] * bfhi(a.x); s += hf[2] * bflo(a.y); s += hf[3] * bfhi(a.y);
        s += hf[4] * bflo(a.z); s += hf[5] * bfhi(a.z); s += hf[6] * bflo(a.w); s += hf[7] * bfhi(a.w);
        s += hf[8] * bflo(b.x); s += hf[9] * bfhi(b.x); s += hf[10] * bflo(b.y); s += hf[11] * bfhi(b.y);
        s += hf[12] * bflo(b.z); s += hf[13] * bfhi(b.z); s += hf[14] * bflo(b.w); s += hf[15] * bfhi(b.w);
        acc[k] = s;
      }
      float a8[8], a4[4], a2[2], tot;
      {
        const bool up = (lane & 32) != 0;
#pragma unroll
        for (int i = 0; i < 8; ++i) { float send = up ? acc[i] : acc[i + 8]; float keep = up ? acc[i + 8] : acc[i]; a8[i] = keep + __shfl_xor(send, 32); }
      }
      {
        const bool up = (lane & 16) != 0;
#pragma unroll
        for (int i = 0; i < 4; ++i) { float send = up ? a8[i] : a8[i + 4]; float keep = up ? a8[i + 4] : a8[i]; a4[i] = keep + __shfl_xor(send, 16); }
      }
      {
        const bool up = (lane & 8) != 0;
#pragma unroll
        for (int i = 0; i < 2; ++i) { float send = up ? a4[i] : a4[i + 2]; float keep = up ? a4[i + 2] : a4[i]; a2[i] = keep + __shfl_xor(send, 8); }
      }
      {
        const bool up = (lane & 4) != 0;
        float send = up ? a2[0] : a2[1]; float keep = up ? a2[1] : a2[0]; tot = keep + __shfl_xor(send, 4);
      }
      tot += __shfl_xor(tot, 2);
      tot += __shfl_xor(tot, 1);
      const float gk = __shfl(greg, lane >> 2);
      const float coef = gk * gelu_tanh(tot);
      const int coefb = (int)__float_as_uint(coef);
#pragma unroll
      for (int k = 0; k < 16; ++k) {
        const int e = __builtin_amdgcn_readlane(ereg, k);
        const float ck = __uint_as_float((unsigned)__builtin_amdgcn_readlane(coefb, 4 * k));
        const u16* vr = vb + (size_t)e * D;
        uint4 a = *(const uint4*)(vr + lane * 8), b = *(const uint4*)(vr + 512 + lane * 8);
        o[0] += ck * bflo(a.x); o[1] += ck * bfhi(a.x); o[2] += ck * bflo(a.y); o[3] += ck * bfhi(a.y);
        o[4] += ck * bflo(a.z); o[5] += ck * bfhi(a.z); o[6] += ck * bflo(a.w); o[7] += ck * bfhi(a.w);
        o[8] += ck * bflo(b.x); o[9] += ck * bfhi(b.x); o[10] += ck * bflo(b.y); o[11] += ck * bfhi(b.y);
        o[12] += ck * bflo(b.z); o[13] += ck * bfhi(b.z); o[14] += ck * bflo(b.w); o[15] += ck * bfhi(b.w);
      }
    }
    float* xo = p.out + (size_t)T * D;
    const float* g2 = mod + seq * 6144 + 5120;
    float x2[16]; float ss = 0.f;
#pragma unroll
    for (int part = 0; part < 2; ++part) {
      const int col = part * 512 + lane * 8;
      float4 xa = *(const float4*)(xo + col), xb = *(const float4*)(xo + col + 4);
      float4 ga = *(const float4*)(g2 + col), gb = *(const float4*)(g2 + col + 4);
      x2[part * 8 + 0] = xa.x + ga.x * o[part * 8 + 0]; x2[part * 8 + 1] = xa.y + ga.y * o[part * 8 + 1];
      x2[part * 8 + 2] = xa.z + ga.z * o[part * 8 + 2]; x2[part * 8 + 3] = xa.w + ga.w * o[part * 8 + 3];
      x2[part * 8 + 4] = xb.x + gb.x * o[part * 8 + 4]; x2[part * 8 + 5] = xb.y + gb.y * o[part * 8 + 5];
      x2[part * 8 + 6] = xb.z + gb.z * o[part * 8 + 6]; x2[part * 8 + 7] = xb.w + gb.w * o[part * 8 + 7];
    }
#pragma unroll
    for (int i = 0; i < 16; ++i) ss += x2[i] * x2[i];
    ss = wave_sum(ss);
    const float rstd = rsqrtf(ss * (1.f / 1024.f) + 1e-6f);
#pragma unroll
    for (int part = 0; part < 2; ++part) {
      const int col = part * 512 + lane * 8;
      float4 na = *(const float4*)(p.norm_f_g + col), nb2 = *(const float4*)(p.norm_f_g + col + 4);
      float4 ya = make_float4(x2[part * 8 + 0] * rstd * na.x, x2[part * 8 + 1] * rstd * na.y, x2[part * 8 + 2] * rstd * na.z, x2[part * 8 + 3] * rstd * na.w);
      float4 yb = make_float4(x2[part * 8 + 4] * rstd * nb2.x, x2[part * 8 + 5] * rstd * nb2.y, x2[part * 8 + 6] * rstd * nb2.z, x2[part * 8 + 7] * rstd * nb2.w);
      *(float4*)(xo + col) = ya; *(float4*)(xo + col + 4) = yb;
    }
  }
}

constexpr int SMEM_BYTES = (SMEM_LRU > SMEM_GEMM) ? SMEM_LRU : SMEM_GEMM;

__global__ void __launch_bounds__(256, 2) mega(Params p) {
  __shared__ __attribute__((aligned(16))) char smem[SMEM_BYTES];
#define RUN_PHASE(ph_, ...)                                         \
  if (p.phase_lo <= (ph_) && (ph_) < p.phase_hi) {                  \
    __VA_ARGS__;                                                    \
    if ((ph_) + 1 < p.phase_hi) cg::this_grid().sync();             \
  }
  RUN_PHASE(0, phase0(p, smem))
  RUN_PHASE(1, phase_norm<false>(p))
  RUN_PHASE(2, phase_gemm1(p, smem))
  RUN_PHASE(3, phase_fft1(p, smem); phase_lru_local(p, smem))
  RUN_PHASE(4, phase_carry(p); phase_fft3(p, smem))
  RUN_PHASE(5, phase_lru_fix(p))
  RUN_PHASE(6, phase_gemm2(p, smem))
  RUN_PHASE(7, phase_norm<true>(p))
  RUN_PHASE(8, phase_gemm3(p, smem))
  RUN_PHASE(9, phase_topk(p))
  RUN_PHASE(10, phase_peer(p))
}

extern "C" void kernel_launch(void* const* d_in, const int* in_sizes, int n_in, void* d_out, int out_size,
                              void* d_ws, size_t ws_size, hipStream_t stream) {
  static int grid_blocks = 0;
  if (!grid_blocks) {
    int dev = 0, cus = 0, per_cu = 0;
    hipGetDevice(&dev);
    hipDeviceGetAttribute(&cus, hipDeviceAttributeMultiprocessorCount, dev);
    hipOccupancyMaxActiveBlocksPerMultiprocessor(&per_cu, mega, 256, 0);
    if (per_cu < 1) per_cu = 1;
    if (per_cu > 2) per_cu = 2;
    grid_blocks = cus * per_cu;
  }
  if (ws_size < WS_TOTAL) { fprintf(stderr, "workspace too small: %zu < %zu\n", ws_size, (size_t)WS_TOTAL); return; }
  Params p{};
  p.x_prompt = (const float*)d_in[0]; p.x_sample = (const float*)d_in[1]; p.c_prompt = (const float*)d_in[2]; p.c_sample = (const float*)d_in[3];
  p.ada_w = (const float*)d_in[4]; p.ada_b = (const float*)d_in[5]; p.norm1_g = (const float*)d_in[6]; p.w_in = (const float*)d_in[7];
  p.fnet_w = (const float*)d_in[8]; p.conv_w = (const float*)d_in[9]; p.conv_b = (const float*)d_in[10]; p.lru_wa = (const float*)d_in[11];
  p.lru_ba = (const float*)d_in[12]; p.lru_wx = (const float*)d_in[13]; p.lru_bx = (const float*)d_in[14]; p.lru_lambda = (const float*)d_in[15];
  p.w_out = (const float*)d_in[16]; p.norm2_g = (const float*)d_in[17]; p.peer_wq = (const float*)d_in[18]; p.peer_k1 = (const float*)d_in[19];
  p.peer_k2 = (const float*)d_in[20]; p.peer_u = (const float*)d_in[21]; p.peer_v = (const float*)d_in[22]; p.norm_f_g = (const float*)d_in[23];
  p.out = (float*)d_out; p.ws = (char*)d_ws;
#if COOP
  p.phase_lo = 0; p.phase_hi = NPHASE;
  void* args[] = {&p};
  hipError_t e = hipLaunchCooperativeKernel((void*)mega, dim3(grid_blocks), dim3(256), args, 0, stream);
  if (e != hipSuccess) fprintf(stderr, "cooperative launch failed: %s (grid %d)\n", hipGetErrorString(e), grid_blocks);
#else
  for (int ph = 0; ph < NPHASE; ++ph) {
    p.phase_lo = ph; p.phase_hi = ph + 1;
    hipLaunchKernelGGL(mega, dim3(grid_blocks), dim3(256), 0, stream, p);
  }
#endif
}
```

```cpp
#include <hip/hip_runtime.h>
#include <hip/hip_cooperative_groups.h>
#include <cstdio>
#include <cstdint>
namespace cg = cooperative_groups;

#ifndef COOP
#define COOP 1
#endif

typedef unsigned short u16;
typedef __attribute__((ext_vector_type(8))) short bf16x8;
typedef __attribute__((ext_vector_type(4))) short s16x4;
typedef __attribute__((ext_vector_type(4))) float f32x4;
typedef __attribute__((ext_vector_type(16))) float f32x16;
typedef short v4i16_t __attribute__((ext_vector_type(4)));
typedef unsigned int u32x4 __attribute__((ext_vector_type(4)));
typedef float f32x2 __attribute__((ext_vector_type(2)));

constexpr int D = 1024;
constexpr int SEQ = 16384;
constexpr int NSEQ = 3;
constexpr int NT = NSEQ * SEQ;
constexpr int NCH = 256;
constexpr int NPHASE = 11;

constexpr size_t OFF_MOD   = 0;
constexpr size_t OFF_W1T   = 1ull << 20;
constexpr size_t OFF_W2T   = OFF_W1T + (4ull << 20);
constexpr size_t OFF_WQT   = OFF_W2T + (2ull << 20);
constexpr size_t OFF_K1B   = OFF_WQT + (4ull << 20);
constexpr size_t OFF_K2B   = OFF_K1B + (256ull << 10);
constexpr size_t OFF_WAT   = OFF_K2B + (256ull << 10);
constexpr size_t OFF_A1    = OFF_WAT + (256ull << 10);
constexpr size_t OFF_SUMP  = OFF_A1 + (256ull << 10);
constexpr size_t OFF_SUMH  = OFF_SUMP + (3ull << 20);
constexpr size_t OFF_CARRY = OFF_SUMH + (3ull << 20);
constexpr size_t OFF_MTAB  = OFF_CARRY + (3ull << 20);
constexpr size_t OFF_UB    = OFF_MTAB + (8ull << 20);
constexpr size_t OFF_VB    = OFF_UB + (32ull << 20);
constexpr size_t OFF_RA    = OFF_VB + (32ull << 20);
constexpr size_t OFF_RB    = OFF_RA + (96ull << 20);
constexpr size_t OFF_RC    = OFF_RB + (96ull << 20);
constexpr size_t WS_TOTAL  = OFF_RC + (192ull << 20);

struct Params {
  const float* x_prompt; const float* x_sample; const float* c_prompt; const float* c_sample;
  const float* ada_w; const float* ada_b; const float* norm1_g; const float* w_in; const float* fnet_w;
  const float* conv_w; const float* conv_b; const float* lru_wa; const float* lru_ba; const float* lru_wx;
  const float* lru_bx; const float* lru_lambda; const float* w_out; const float* norm2_g; const float* peer_wq;
  const float* peer_k1; const float* peer_k2; const float* peer_u; const float* peer_v; const float* norm_f_g;
  float* out; char* ws;
  int phase_lo; int phase_hi;
};

__device__ __forceinline__ unsigned f2bf(float f) { unsigned u = __float_as_uint(f); u += 0x7FFFu + ((u >> 16) & 1u); return u >> 16; }
__device__ __forceinline__ unsigned pack2(float a, float b) { return f2bf(a) | (f2bf(b) << 16); }
__device__ __forceinline__ float bflo(unsigned u) { return __uint_as_float(u << 16); }
__device__ __forceinline__ float bfhi(unsigned u) { return __uint_as_float(u & 0xFFFF0000u); }
__device__ __forceinline__ float sigmoidf_(float x) { return 1.f / (1.f + __expf(-x)); }
__device__ __forceinline__ float gelu_tanh(float x) {
  float y = 0.7978845608028654f * (x + 0.044715f * x * x * x);
  return x / (1.f + __expf(-2.f * y));
}
__device__ __forceinline__ float wave_sum(float v) {
#pragma unroll
  for (int o = 32; o > 0; o >>= 1) v += __shfl_xor(v, o);
  return v;
}
__device__ __forceinline__ const float* xrow(const Params& p, int T) {
  return (T < 2 * SEQ) ? p.x_prompt + (size_t)T * D : p.x_sample + (size_t)(T - 2 * SEQ) * D;
}

constexpr int BK = 64;
constexpr int LDSA = BK + 8;
constexpr int LDSB_NN = 128 + 8;
constexpr int SMEM_GEMM = 2 * 128 * LDSA * 2;

template <int BMODE, class ARow, class BRow, class Epi>
__device__ __forceinline__ void gemm_tile(ARow arow, BRow brow, int K, Epi epi, char* smem) {
  u16* sA = (u16*)smem;
  u16* sB = sA + 128 * LDSA;
  const int tid = threadIdx.x, lane = tid & 63, w = tid >> 6;
  const int wm = w >> 1, wn = w & 1;
  f32x4 acc[4][4];
#pragma unroll
  for (int i = 0; i < 4; ++i)
#pragma unroll
    for (int j = 0; j < 4; ++j) acc[i][j] = (f32x4){0.f, 0.f, 0.f, 0.f};

  const u16* pa[4];
  const u16* pb[4];
#pragma unroll
  for (int i = 0; i < 4; ++i) {
    int c = tid + 256 * i;
    pa[i] = arow(c >> 3) + (c & 7) * 8;
    if (BMODE == 0) pb[i] = brow(c >> 3) + (c & 7) * 8;
  }
  u32x4 ra[4], rb[4];
#define GLOAD(k0_)                                                                                       \
  _Pragma("unroll") for (int i = 0; i < 4; ++i) {                                                        \
    ra[i] = *(const u32x4*)(pa[i] + (k0_));                                                              \
    if (BMODE == 0) rb[i] = *(const u32x4*)(pb[i] + (k0_));                                              \
    else { int c = tid + 256 * i; rb[i] = *(const u32x4*)(brow((k0_) + (c >> 4)) + (c & 15) * 8); }      \
  }
  GLOAD(0)
  for (int k0 = 0; k0 < K; k0 += BK) {
    __syncthreads();
#pragma unroll
    for (int i = 0; i < 4; ++i) {
      int c = tid + 256 * i;
      *(u32x4*)(sA + (c >> 3) * LDSA + (c & 7) * 8) = ra[i];
      if (BMODE == 0) *(u32x4*)(sB + (c >> 3) * LDSA + (c & 7) * 8) = rb[i];
      else *(u32x4*)(sB + (c >> 4) * LDSB_NN + (c & 15) * 8) = rb[i];
    }
    __syncthreads();
    if (k0 + BK < K) { GLOAD(k0 + BK) }
#pragma unroll
    for (int kk = 0; kk < 2; ++kk) {
      bf16x8 af[4], bfr[4];
#pragma unroll
      for (int mt = 0; mt < 4; ++mt)
        af[mt] = *(const bf16x8*)(sA + (wm * 64 + mt * 16 + (lane & 15)) * LDSA + kk * 32 + (lane >> 4) * 8);
#pragma unroll
      for (int nt = 0; nt < 4; ++nt) {
        if (BMODE == 0) {
          bfr[nt] = *(const bf16x8*)(sB + (wn * 64 + nt * 16 + (lane & 15)) * LDSA + kk * 32 + (lane >> 4) * 8);
        } else {
          int g = lane >> 4, i16 = lane & 15, q = i16 >> 2, pq = i16 & 3;
          const u16* ad = sB + (kk * 32 + 8 * g + q) * LDSB_NN + wn * 64 + nt * 16 + 4 * pq;
          v4i16_t lo = __builtin_amdgcn_ds_read_tr16_b64_v4i16((__attribute__((address_space(3))) v4i16_t*)(ad));
          v4i16_t hi = __builtin_amdgcn_ds_read_tr16_b64_v4i16((__attribute__((address_space(3))) v4i16_t*)(ad + 4 * LDSB_NN));
          bfr[nt] = (bf16x8){lo[0], lo[1], lo[2], lo[3], hi[0], hi[1], hi[2], hi[3]};
        }
      }
#pragma unroll
      for (int mt = 0; mt < 4; ++mt)
#pragma unroll
        for (int nt = 0; nt < 4; ++nt)
          acc[mt][nt] = __builtin_amdgcn_mfma_f32_16x16x32_bf16(af[mt], bfr[nt], acc[mt][nt], 0, 0, 0);
    }
  }
#pragma unroll
  for (int mt = 0; mt < 4; ++mt)
#pragma unroll
    for (int nt = 0; nt < 4; ++nt)
#pragma unroll
      for (int j = 0; j < 4; ++j)
        epi(wm * 64 + mt * 16 + (lane >> 4) * 4 + j, wn * 64 + nt * 16 + (lane & 15), acc[mt][nt][j]);
}

__device__ void phase0(const Params& p, char* smem) {
  const int tid = threadIdx.x, nb = gridDim.x, bid = blockIdx.x;
  float* sf = (float*)smem;
  float* mod = (float*)(p.ws + OFF_MOD);
  for (int item = bid; item < 96; item += nb) {
    int col = item * 64 + (tid & 63), ks = tid >> 6;
    float a0 = 0.f, a1 = 0.f, a2 = 0.f;
    for (int k = ks * 256; k < ks * 256 + 256; ++k) {
      float wv = p.ada_w[(size_t)k * 6144 + col];
      float c0 = p.c_prompt[k], c1 = p.c_prompt[1024 + k], c2 = p.c_sample[k];
      a0 += c0 * sigmoidf_(c0) * wv; a1 += c1 * sigmoidf_(c1) * wv; a2 += c2 * sigmoidf_(c2) * wv;
    }
    __syncthreads();
    sf[tid * 3 + 0] = a0; sf[tid * 3 + 1] = a1; sf[tid * 3 + 2] = a2;
    __syncthreads();
    if (tid < 64) {
      float bsum = p.ada_b[col];
#pragma unroll
      for (int s = 0; s < 3; ++s) {
        float v = sf[tid * 3 + s] + sf[(tid + 64) * 3 + s] + sf[(tid + 128) * 3 + s] + sf[(tid + 192) * 3 + s];
        mod[s * 6144 + col] = v + bsum;
      }
    }
  }
  __syncthreads();
  float* ct = sf + 1024; float* st = sf + 1024 + 64;
  if (tid < 64) { ct[tid] = cospif(tid / 32.f); st[tid] = sinpif(tid / 32.f); }
  __syncthreads();
  const size_t gtid = (size_t)bid * 256 + tid, gstride = (size_t)nb * 256;
  {
    u16* w1T = (u16*)(p.ws + OFF_W1T);
    for (size_t idx = gtid; idx < 2048ull * 1024; idx += gstride) {
      int n = (int)(idx >> 10), k = (int)(idx & 1023);
      float v;
      if (n < 1024) {
        int comp = n >> 9, g = (n >> 6) & 7, kk = n & 63;
        const float* src = p.w_in + (size_t)k * 1536 + g * 64;
        float s = 0.f;
        for (int c = 0; c < 64; ++c) {
          int j = (c * kk) & 63;
          float tw = comp ? -st[j] : ct[j];
          s += src[c] * tw;
        }
        v = s;
      } else {
        v = p.w_in[(size_t)k * 1536 + (n - 512)];
      }
      w1T[idx] = (u16)f2bf(v);
    }
  }
  {
    u16* w2T = (u16*)(p.ws + OFF_W2T);
    for (size_t idx = gtid; idx < 1024ull * 1024; idx += gstride) {
      int n = (int)(idx >> 10), k = (int)(idx & 1023);
      float v;
      if (k < 512) {
        int g = k >> 6;
        const float* fw = p.fnet_w + (size_t)k * 64;
        const float* wo = p.w_out + (size_t)(g * 64) * 1024 + n;
        float s = 0.f;
        for (int d = 0; d < 64; ++d) s += fw[d] * wo[(size_t)d * 1024];
        v = s * (1.f / 1024.f);
      } else {
        v = p.w_out[(size_t)k * 1024 + n];
      }
      w2T[idx] = (u16)f2bf(v);
    }
  }
  {
    u16* wqT = (u16*)(p.ws + OFF_WQT);
    for (size_t idx = gtid; idx < 2048ull * 1024; idx += gstride) {
      int n = (int)(idx >> 10), k = (int)(idx & 1023);
      wqT[idx] = (u16)f2bf(p.peer_wq[(size_t)k * 2048 + n]);
    }
  }
  {
    u16* k1b = (u16*)(p.ws + OFF_K1B); u16* k2b = (u16*)(p.ws + OFF_K2B);
    for (size_t idx = gtid; idx < 131072; idx += gstride) { k1b[idx] = (u16)f2bf(p.peer_k1[idx]); k2b[idx] = (u16)f2bf(p.peer_k2[idx]); }
  }
  {
    u16* waT = (u16*)(p.ws + OFF_WAT);
    for (size_t idx = gtid; idx < 131072; idx += gstride) {
      int i = idx & 63, j = (idx >> 6) & 63, h = (idx >> 12) & 7, gate = (idx >> 15) & 1, d = (int)(idx >> 16);
      const float* src = gate ? p.lru_wx : p.lru_wa;
      waT[idx] = (u16)f2bf(src[((size_t)(d * 8 + h) * 64 + i) * 64 + j]);
    }
  }
  {
    u16* A1 = (u16*)(p.ws + OFF_A1);
    for (size_t idx = gtid; idx < 65536; idx += gstride) {
      int m = (int)(idx >> 8), k = (int)(idx & 255);
      int cp = m >> 7, k1 = m & 127, comp = k >> 7, s1 = k & 127;
      int j = (k1 * s1) & 127;
      float C = cospif(j / 64.f), S = sinpif(j / 64.f);
      float v = (cp == comp) ? C : (cp == 0 ? S : -S);
      A1[idx] = (u16)f2bf(v);
    }
    u16* Mt = (u16*)(p.ws + OFF_MTAB);
    for (size_t idx = gtid; idx < 128ull * 128 * 256; idx += gstride) {
      int k = (int)(idx & 255), k2 = (int)((idx >> 8) & 127), k1 = (int)(idx >> 15);
      int comp = k >> 7, s2 = k & 127;
      int j = (s2 * (k1 + 128 * k2)) & 16383;
      float v = comp ? sinpif(j / 8192.f) : cospif(j / 8192.f);
      Mt[idx] = (u16)f2bf(v);
    }
  }
  {
    const int lane = tid & 63;
    const int gwv = bid * 4 + (tid >> 6), nwv = nb * 4;
    for (int row = gwv; row < 32768; row += nwv) {
      const int tbl = row >> 14, e = row & 16383;
      const float* src = (tbl ? p.peer_v : p.peer_u) + (size_t)e * D + lane * 16;
      float4 f0 = *(const float4*)src, f1 = *(const float4*)(src + 4), f2 = *(const float4*)(src + 8), f3 = *(const float4*)(src + 12);
      float m = fmaxf(fmaxf(fmaxf(fabsf(f0.x), fabsf(f0.y)), fmaxf(fabsf(f0.z), fabsf(f0.w))), fmaxf(fmaxf(fabsf(f1.x), fabsf(f1.y)), fmaxf(fabsf(f1.z), fabsf(f1.w))));
      m = fmaxf(m, fmaxf(fmaxf(fmaxf(fabsf(f2.x), fabsf(f2.y)), fmaxf(fabsf(f2.z), fabsf(f2.w))), fmaxf(fmaxf(fabsf(f3.x), fabsf(f3.y)), fmaxf(fabsf(f3.z), fabsf(f3.w)))));
#pragma unroll
      for (int o = 32; o > 0; o >>= 1) m = fmaxf(m, __shfl_xor(m, o));
      const float inv = (m > 0.f) ? 224.f / m : 0.f;
      const float scl = (m > 0.f) ? m * (1.f / 224.f) : 0.f;
      int d0 = __builtin_amdgcn_cvt_pk_fp8_f32(f0.x * inv, f0.y * inv, 0, false); d0 = __builtin_amdgcn_cvt_pk_fp8_f32(f0.z * inv, f0.w * inv, d0, true);
      int d1 = __builtin_amdgcn_cvt_pk_fp8_f32(f1.x * inv, f1.y * inv, 0, false); d1 = __builtin_amdgcn_cvt_pk_fp8_f32(f1.z * inv, f1.w * inv, d1, true);
      int d2 = __builtin_amdgcn_cvt_pk_fp8_f32(f2.x * inv, f2.y * inv, 0, false); d2 = __builtin_amdgcn_cvt_pk_fp8_f32(f2.z * inv, f2.w * inv, d2, true);
      int d3 = __builtin_amdgcn_cvt_pk_fp8_f32(f3.x * inv, f3.y * inv, 0, false); d3 = __builtin_amdgcn_cvt_pk_fp8_f32(f3.z * inv, f3.w * inv, d3, true);
      char* dst = p.ws + (tbl ? OFF_VB : OFF_UB);
      *(uint4*)(dst + (size_t)e * 1024 + lane * 16) = make_uint4((unsigned)d0, (unsigned)d1, (unsigned)d2, (unsigned)d3);
      if (lane == 0) ((float*)(dst + (16ull << 20)))[e] = scl;
    }
  }
}

template <bool SECOND>
__device__ void phase_norm(const Params& p) {
  const int lane = threadIdx.x & 63;
  const int gw = blockIdx.x * 4 + (threadIdx.x >> 6), nw = gridDim.x * 4;
  const float* mod = (const float*)(p.ws + OFF_MOD);
  const float* gain = SECOND ? p.norm2_g : p.norm1_g;
  u16* dst = (u16*)(p.ws + OFF_RA);
  for (int T = gw; T < NT; T += nw) {
    const float* xr = SECOND ? (p.out + (size_t)T * D) : xrow(p, T);
    const int seq = T >> 14;
    const float* sh = mod + seq * 6144 + (SECOND ? 3072 : 0);
    const float* sc = mod + seq * 6144 + (SECOND ? 4096 : 1024);
    float4 v[4]; float ss = 0.f;
#pragma unroll
    for (int i = 0; i < 4; ++i) {
      v[i] = ((const float4*)xr)[lane + 64 * i];
      ss += v[i].x * v[i].x + v[i].y * v[i].y + v[i].z * v[i].z + v[i].w * v[i].w;
    }
    ss = wave_sum(ss);
    float rstd = rsqrtf(ss * (1.f / 1024.f) + 1e-6f);
#pragma unroll
    for (int i = 0; i < 4; ++i) {
      int col = 4 * (lane + 64 * i);
      float4 g = *(const float4*)(gain + col), s1 = *(const float4*)(sc + col), s0 = *(const float4*)(sh + col);
      float y0 = v[i].x * rstd * g.x * (1.f + s1.x) + s0.x;
      float y1 = v[i].y * rstd * g.y * (1.f + s1.y) + s0.y;
      float y2 = v[i].z * rstd * g.z * (1.f + s1.z) + s0.z;
      float y3 = v[i].w * rstd * g.w * (1.f + s1.w) + s0.w;
      *(uint2*)(dst + (size_t)T * D + col) = make_uint2(pack2(y0, y1), pack2(y2, y3));
    }
  }
}

__device__ void phase_gemm1(const Params& p, char* smem) {
  const u16* h1 = (const u16*)(p.ws + OFF_RA);
  const u16* w1T = (const u16*)(p.ws + OFF_W1T);
  u16* Z = (u16*)(p.ws + OFF_RB);
  u16* ux = (u16*)(p.ws + OFF_RC);
  u16* gg = ux + (size_t)NT * 512;
  for (int tile = blockIdx.x; tile < 384 * 16; tile += gridDim.x) {
    const int mt = tile >> 4, nt = tile & 15;
    const int T0 = mt * 128, n0 = nt * 128;
    auto arow = [&](int r) { return h1 + (size_t)(T0 + r) * D; };
    auto brow = [&](int r) { return w1T + (size_t)(n0 + r) * D; };
    if (nt < 8) {
      gemm_tile<0>(arow, brow, D, [&](int r, int c, float v) { Z[(size_t)(T0 + r) * 1024 + n0 + c] = (u16)f2bf(v); }, smem);
    } else if (nt < 12) {
      gemm_tile<0>(arow, brow, D, [&](int r, int c, float v) { ux[(size_t)(T0 + r) * 512 + (n0 - 1024) + c] = (u16)f2bf(v); }, smem);
    } else {
      gemm_tile<0>(arow, brow, D, [&](int r, int c, float v) { gg[(size_t)(T0 + r) * 512 + (n0 - 1536) + c] = (u16)f2bf(gelu_tanh(v)); }, smem);
    }
  }
}

__device__ void phase_fft1(const Params& p, char* smem) {
  const u16* Z = (const u16*)(p.ws + OFF_RB);
  const u16* A1 = (const u16*)(p.ws + OFF_A1);
  u16* Tb = (u16*)(p.ws + OFF_RA);
  for (int tile = blockIdx.x; tile < 3072; tile += gridDim.x) {
    const int mtile = tile & 1, chb = (tile >> 1) & 3, s2 = (tile >> 3) & 127, b = tile >> 10;
    const u16* Zb = Z + ((size_t)b * SEQ + s2) * 1024 + chb * 128;
    auto arow = [&](int r) { return A1 + (size_t)(mtile * 128 + r) * 256; };
    auto brow = [&](int k) { return Zb + (size_t)(k & 127) * (128 * 1024) + (k >> 7) * 512; };
    u16* To = Tb + (((size_t)b * 128) * 128 + s2) * 1024 + mtile * 512 + chb * 128;
    gemm_tile<1>(arow, brow, 256, [&](int r, int c, float v) { To[(size_t)r * (128 * 1024) + c] = (u16)f2bf(v); }, smem);
  }
}

constexpr int XP = 68;
constexpr int SMEM_LRU = 64 * XP * 4 + 2 * 64 * 64 * 4;
__device__ void phase_lru_local(const Params& p, char* smem) {
  float* sX = (float*)smem;
  float* sAa = sX + 64 * XP;
  float* sBb = sAa + 64 * 64;
  u16* stg = (u16*)sAa;
  const int tid = threadIdx.x, lane = tid & 63, w = tid >> 6;
  const u16* ux = (const u16*)(p.ws + OFF_RC);
  const u16* waT = (const u16*)(p.ws + OFF_WAT);
  float* sumP = (float*)(p.ws + OFF_SUMP);
  float* sumH = (float*)(p.ws + OFF_SUMH);
  u16* HP = (u16*)p.out;
  for (int tile = blockIdx.x; tile < NSEQ * NCH * 8; tile += gridDim.x) {
    const int h = tile & 7, c = (tile >> 3) & (NCH - 1), b = tile >> 11;
    const int T0 = b * SEQ + c * 64;
    __syncthreads();
    for (int idx = tid; idx < 67 * 8; idx += 256) {
      int r = idx >> 3, c8 = idx & 7;
      int t = c * 64 - 2 + r;
      uint4 v = make_uint4(0, 0, 0, 0);
      if (t >= 0 && t < SEQ) v = *(const uint4*)(ux + ((size_t)b * SEQ + t) * 512 + h * 64 + c8 * 8);
      *(uint4*)(stg + r * 64 + c8 * 8) = v;
    }
    __syncthreads();
    {
      const int ch = tid & 63, chg = h * 64 + ch;
      const float w0 = p.conv_w[chg], w1 = p.conv_w[512 + chg], w2 = p.conv_w[1024 + chg], w3 = p.conv_w[1536 + chg];
      const float cb = p.conv_b[chg];
#pragma unroll 4
      for (int i = 0; i < 16; ++i) {
        int t = (tid >> 6) + 4 * i;
        float v = cb + w0 * __uint_as_float((unsigned)stg[t * 64 + ch] << 16) + w1 * __uint_as_float((unsigned)stg[(t + 1) * 64 + ch] << 16)
                + w2 * __uint_as_float((unsigned)stg[(t + 2) * 64 + ch] << 16) + w3 * __uint_as_float((unsigned)stg[(t + 3) * 64 + ch] << 16);
        sX[t * XP + ch] = v;
      }
    }
    __syncthreads();
    bf16x8 af[2];
#pragma unroll
    for (int kk = 0; kk < 2; ++kk) {
      const float* src = sX + (16 * w + (lane & 15)) * XP + kk * 32 + (lane >> 4) * 8;
      float4 f0 = *(const float4*)src, f1 = *(const float4*)(src + 4);
      af[kk] = (bf16x8){(short)f2bf(f0.x), (short)f2bf(f0.y), (short)f2bf(f0.z), (short)f2bf(f0.w),
                        (short)f2bf(f1.x), (short)f2bf(f1.y), (short)f2bf(f1.z), (short)f2bf(f1.w)};
    }
    for (int d = 0; d < 2; ++d) {
      f32x4 acc[2][4];
#pragma unroll
      for (int g = 0; g < 2; ++g)
#pragma unroll
        for (int nt = 0; nt < 4; ++nt) {
          acc[g][nt] = (f32x4){0.f, 0.f, 0.f, 0.f};
#pragma unroll
          for (int kk = 0; kk < 2; ++kk) {
            const u16* bp = waT + ((size_t)((d * 2 + g) * 8 + h) * 64 + nt * 16 + (lane & 15)) * 64 + kk * 32 + (lane >> 4) * 8;
            bf16x8 bfr = *(const bf16x8*)bp;
            acc[g][nt] = __builtin_amdgcn_mfma_f32_16x16x32_bf16(af[kk], bfr, acc[g][nt], 0, 0, 0);
          }
        }
#pragma unroll
      for (int nt = 0; nt < 4; ++nt) {
        const int ch = nt * 16 + (lane & 15), chg = h * 64 + ch;
        const float ba = p.lru_ba[d * 512 + chg], bx = p.lru_bx[d * 512 + chg];
        const float lam = p.lru_lambda[d * 512 + chg];
        const float cl = -8.f * log1pf(expf(-lam));
#pragma unroll
        for (int j = 0; j < 4; ++j) {
          const int tok = 16 * w + 4 * (lane >> 4) + j;
          float r = sigmoidf_(acc[0][nt][j] + ba);
          float ii = sigmoidf_(acc[1][nt][j] + bx);
          float la = cl * r;
          float a = expf(la);
          float bb = sqrtf(-expm1f(2.f * la)) * ii * sX[tok * XP + ch];
          sAa[tok * 64 + ch] = a; sBb[tok * 64 + ch] = bb;
        }
      }
      __syncthreads();
      if (tid < 64) {
        const int ch = tid;
        float hh = 0.f, P = 1.f;
        if (d == 0) {
          for (int t = 0; t < 64; ++t) {
            float a = sAa[t * 64 + ch], bb = sBb[t * 64 + ch];
            hh = a * hh + bb; P *= a;
            sBb[t * 64 + ch] = hh; sAa[t * 64 + ch] = P;
          }
        } else {
          for (int t = 63; t >= 0; --t) {
            float a = sAa[t * 64 + ch], bb = sBb[t * 64 + ch];
            hh = a * hh + bb; P *= a;
            sBb[t * 64 + ch] = hh; sAa[t * 64 + ch] = P;
          }
        }
        size_t si = ((size_t)(b * NCH + c) * 2 + d) * 512 + h * 64 + ch;
        sumP[si] = P; sumH[si] = hh;
      }
      __syncthreads();
      u16* Hd = HP + (size_t)(d * 2 + 0) * NT * 512;
      u16* Pd = HP + (size_t)(d * 2 + 1) * NT * 512;
#pragma unroll
      for (int i = 0; i < 2; ++i) {
        int idx = tid + 256 * i; int t = idx >> 3, c8 = idx & 7;
        const float* hs = sBb + t * 64 + c8 * 8; const float* ps = sAa + t * 64 + c8 * 8;
        size_t o = (size_t)(T0 + t) * 512 + h * 64 + c8 * 8;
        *(uint4*)(Hd + o) = make_uint4(pack2(hs[0], hs[1]), pack2(hs[2], hs[3]), pack2(hs[4], hs[5]), pack2(hs[6], hs[7]));
        *(uint4*)(Pd + o) = make_uint4(pack2(ps[0], ps[1]), pack2(ps[2], ps[3]), pack2(ps[4], ps[5]), pack2(ps[6], ps[7]));
      }
      __syncthreads();
    }
  }
}

__device__ void phase_carry(const Params& p) {
  const float* sumP = (const float*)(p.ws + OFF_SUMP);
  const float* sumH = (const float*)(p.ws + OFF_SUMH);
  float* carry = (float*)(p.ws + OFF_CARRY);
  const int gid = blockIdx.x * 256 + threadIdx.x;
  if (gid >= NSEQ * 2 * 512) return;
  const int chg = gid & 511, d = (gid >> 9) & 1, b = gid >> 10;
  float cin = 0.f;
  if (d == 0) {
#pragma unroll 4
    for (int c = 0; c < NCH; ++c) {
      size_t si = ((size_t)(b * NCH + c) * 2 + d) * 512 + chg;
      float P = sumP[si], H = sumH[si];
      carry[si] = cin; cin = P * cin + H;
    }
  } else {
#pragma unroll 4
    for (int c = NCH - 1; c >= 0; --c) {
      size_t si = ((size_t)(b * NCH + c) * 2 + d) * 512 + chg;
      float P = sumP[si], H = sumH[si];
      carry[si] = cin; cin = P * cin + H;
    }
  }
}

__device__ void phase_fft3(const Params& p, char* smem) {
  const u16* Tb = (const u16*)(p.ws + OFF_RA);
  const u16* Mt = (const u16*)(p.ws + OFF_MTAB);
  u16* Y = (u16*)(p.ws + OFF_RB);
  for (int tile = blockIdx.x; tile < 1536; tile += gridDim.x) {
    const int chb = tile & 3, k1 = (tile >> 2) & 127, b = tile >> 9;
    const u16* Tk = Tb + ((size_t)(b * 128 + k1) * 128) * 1024 + chb * 128;
    auto arow = [&](int r) { return Mt + ((size_t)k1 * 128 + r) * 256; };
    auto brow = [&](int k) { return Tk + (size_t)(k & 127) * 1024 + (k >> 7) * 512; };
    u16* Yo = Y + ((size_t)b * SEQ + k1) * 1024 + chb * 128;
    gemm_tile<1>(arow, brow, 256, [&](int r, int c, float v) { Yo[(size_t)r * (128 * 1024) + c] = (u16)f2bf(v); }, smem);
  }
}

__device__ void phase_lru_fix(const Params& p) {
  const u16* HP = (const u16*)p.out;
  const u16* gg = (const u16*)(p.ws + OFF_RC) + (size_t)NT * 512;
  const float* carry = (const float*)(p.ws + OFF_CARRY);
  u16* Y = (u16*)(p.ws + OFF_RB);
  const size_t gtid = (size_t)blockIdx.x * 256 + threadIdx.x, gstride = (size_t)gridDim.x * 256;
  for (size_t idx = gtid; idx < (size_t)NT * 64; idx += gstride) {
    const int T = (int)(idx >> 6), ch0 = (int)(idx & 63) * 8;
    const int b = T >> 14, c = (T & (SEQ - 1)) >> 6;
    const size_t o = (size_t)T * 512 + ch0;
    uint4 hf = *(const uint4*)(HP + o), pf = *(const uint4*)(HP + (size_t)NT * 512 + o);
    uint4 hr = *(const uint4*)(HP + (size_t)2 * NT * 512 + o), pr = *(const uint4*)(HP + (size_t)3 * NT * 512 + o);
    uint4 g = *(const uint4*)(gg + o);
    const float* cf = carry + ((size_t)(b * NCH + c) * 2 + 0) * 512 + ch0;
    const float* cr = carry + ((size_t)(b * NCH + c) * 2 + 1) * 512 + ch0;
    float4 cf0 = *(const float4*)cf, cf1 = *(const float4*)(cf + 4), cr0 = *(const float4*)cr, cr1 = *(const float4*)(cr + 4);
    float y0 = (bflo(hf.x) + bflo(pf.x) * cf0.x + bflo(hr.x) + bflo(pr.x) * cr0.x) * bflo(g.x);
    float y1 = (bfhi(hf.x) + bfhi(pf.x) * cf0.y + bfhi(hr.x) + bfhi(pr.x) * cr0.y) * bfhi(g.x);
    float y2 = (bflo(hf.y) + bflo(pf.y) * cf0.z + bflo(hr.y) + bflo(pr.y) * cr0.z) * bflo(g.y);
    float y3 = (bfhi(hf.y) + bfhi(pf.y) * cf0.w + bfhi(hr.y) + bfhi(pr.y) * cr0.w) * bfhi(g.y);
    float y4 = (bflo(hf.z) + bflo(pf.z) * cf1.x + bflo(hr.z) + bflo(pr.z) * cr1.x) * bflo(g.z);
    float y5 = (bfhi(hf.z) + bfhi(pf.z) * cf1.y + bfhi(hr.z) + bfhi(pr.z) * cr1.y) * bfhi(g.z);
    float y6 = (bflo(hf.w) + bflo(pf.w) * cf1.z + bflo(hr.w) + bflo(pr.w) * cr1.z) * bflo(g.w);
    float y7 = (bfhi(hf.w) + bfhi(pf.w) * cf1.w + bfhi(hr.w) + bfhi(pr.w) * cr1.w) * bfhi(g.w);
    *(uint4*)(Y + (size_t)T * 1024 + 512 + ch0) = make_uint4(pack2(y0, y1), pack2(y2, y3), pack2(y4, y5), pack2(y6, y7));
  }
}

__device__ void phase_gemm2(const Params& p, char* smem) {
  const u16* Y = (const u16*)(p.ws + OFF_RB);
  const u16* w2T = (const u16*)(p.ws + OFF_W2T);
  const float* mod = (const float*)(p.ws + OFF_MOD);
  for (int tile = blockIdx.x; tile < 384 * 8; tile += gridDim.x) {
    const int mt = tile >> 3, nt = tile & 7;
    const int T0 = mt * 128, n0 = nt * 128;
    const int seq = T0 >> 14;
    const float* g1 = mod + seq * 6144 + 2048 + n0;
    auto arow = [&](int r) { return Y + (size_t)(T0 + r) * D; };
    auto brow = [&](int r) { return w2T + (size_t)(n0 + r) * D; };
    gemm_tile<0>(arow, brow, D, [&](int r, int c, float v) {
      const float* xr = xrow(p, T0 + r);
      p.out[(size_t)(T0 + r) * D + n0 + c] = xr[n0 + c] + g1[c] * v;
    }, smem);
  }
}

__device__ void phase_gemm3(const Params& p, char* smem) {
  const u16* h2 = (const u16*)(p.ws + OFF_RA);
  const u16* wqT = (const u16*)(p.ws + OFF_WQT);
  u16* q = (u16*)(p.ws + OFF_RC);
  for (int tile = blockIdx.x; tile < 384 * 16; tile += gridDim.x) {
    const int mt = tile >> 4, nt = tile & 15;
    const int T0 = mt * 128, n0 = nt * 128;
    auto arow = [&](int r) { return h2 + (size_t)(T0 + r) * D; };
    auto brow = [&](int r) { return wqT + (size_t)(n0 + r) * D; };
    gemm_tile<0>(arow, brow, D, [&](int r, int c, float v) { q[(size_t)(T0 + r) * 2048 + n0 + c] = (u16)f2bf(v); }, smem);
  }
}

template <int N>
__device__ __forceinline__ void bitonic_sort_desc(float (&v)[N]) {
#pragma unroll
  for (int k = 2; k <= N; k <<= 1) {
#pragma unroll
    for (int j = k >> 1; j > 0; j >>= 1) {
#pragma unroll
      for (int i = 0; i < N; ++i) {
        const int l = i ^ j;
        if (l > i) {
          const bool desc = ((i & k) == 0);
          float mx = fmaxf(v[i], v[l]), mn = fminf(v[i], v[l]);
          v[i] = desc ? mx : mn; v[l] = desc ? mn : mx;
        }
      }
    }
  }
}
template <int N>
__device__ __forceinline__ void bitonic_merge_desc(float (&v)[N]) {
#pragma unroll
  for (int j = N >> 1; j > 0; j >>= 1) {
#pragma unroll
    for (int i = 0; i < N; ++i) {
      const int l = i ^ j;
      if (l > i) { float mx = fmaxf(v[i], v[l]), mn = fminf(v[i], v[l]); v[i] = mx; v[l] = mn; }
    }
  }
}
__device__ __forceinline__ void top16_of_64(const float (&v)[64], float (&top)[16]) {
#pragma unroll
  for (int i = 0; i < 16; ++i) top[i] = v[i];
  bitonic_sort_desc<16>(top);
#pragma unroll
  for (int g = 1; g < 4; ++g) {
    float blk[16];
#pragma unroll
    for (int i = 0; i < 16; ++i) blk[i] = v[16 * g + i];
    bitonic_sort_desc<16>(blk);
#pragma unroll
    for (int i = 0; i < 16; ++i) top[i] = fmaxf(top[i], blk[15 - i]);
    bitonic_merge_desc<16>(top);
  }
}

__device__ __forceinline__ void score_top16(const u16* __restrict__ kb, const u16* __restrict__ qp, int lane, float (&top)[16]) {
  f32x16 acc[4];
#pragma unroll
  for (int mt = 0; mt < 4; ++mt)
#pragma unroll
    for (int r = 0; r < 16; ++r) acc[mt][r] = 0.f;
#pragma unroll 2
  for (int ks = 0; ks < 8; ++ks) {
    bf16x8 bq = *(const bf16x8*)(qp + ks * 16);
#pragma unroll
    for (int mt = 0; mt < 4; ++mt) {
      bf16x8 ak = *(const bf16x8*)(kb + (size_t)(mt * 32 + (lane & 31)) * 128 + ks * 16 + (lane >> 5) * 8);
      acc[mt] = __builtin_amdgcn_mfma_f32_32x32x16_bf16(ak, bq, acc[mt], 0, 0, 0);
    }
  }
  float v[64];
  const int hi = lane >> 5;
#pragma unroll
  for (int mt = 0; mt < 4; ++mt)
#pragma unroll
    for (int r = 0; r < 16; ++r) {
      const unsigned key = 32 * mt + (r & 3) + 8 * (r >> 2) + 4 * hi;
      v[mt * 16 + r] = __uint_as_float((__float_as_uint(acc[mt][r]) & ~127u) | key);
    }
  top16_of_64(v, top);
  float t[16];
#pragma unroll
  for (int i = 0; i < 16; ++i) t[i] = __shfl_xor(top[i], 32);
#pragma unroll
  for (int i = 0; i < 16; ++i) top[i] = fmaxf(top[i], t[15 - i]);
  bitonic_merge_desc<16>(top);
}

__device__ void phase_topk(const Params& p) {
  const int lane = threadIdx.x & 63;
  const int gw = blockIdx.x * 4 + (threadIdx.x >> 6), nw = gridDim.x * 4;
  const u16* q = (const u16*)(p.ws + OFF_RC);
  const u16* k1b = (const u16*)(p.ws + OFF_K1B);
  const u16* k2b = (const u16*)(p.ws + OFF_K2B);
  uint4* eg = (uint4*)(p.ws + OFF_RB);
  for (int item = gw; item < (NT / 32) * 8; item += nw) {
    const int h = item & 7, grp = item >> 3;
    const int T = grp * 32 + (lane & 31);
    const u16* qp = q + (size_t)T * 2048 + h * 256 + (lane >> 5) * 8;
    float t1[16], t2[16];
    score_top16(k1b + (size_t)h * 16384, qp, lane, t1);
    score_top16(k2b + (size_t)h * 16384, qp + 128, lane, t2);
    float cand[64];
#pragma unroll
    for (int i = 0; i < 64; ++i) cand[i] = -3.0e38f;
    {
      int n = 0;
#pragma unroll
      for (int a = 0; a < 16; ++a) {
#pragma unroll
        for (int bb = 0; bb < 16; ++bb) {
          if ((a + 1) * (bb + 1) <= 16) {
            unsigned ia = __float_as_uint(t1[a]) & 127u, ib = __float_as_uint(t2[bb]) & 127u;
            float s = t1[a] + t2[bb];
            cand[n] = __uint_as_float((__float_as_uint(s) & ~16383u) | (ia << 7) | ib);
            ++n;
          }
        }
      }
    }
    float top[16];
    top16_of_64(cand, top);
    float wgt[16]; float mx, sum = 0.f;
    mx = __uint_as_float(__float_as_uint(top[0]) & ~16383u);
#pragma unroll
    for (int i = 0; i < 16; ++i) { wgt[i] = __expf(__uint_as_float(__float_as_uint(top[i]) & ~16383u) - mx); sum += wgt[i]; }
    const float inv = 1.f / sum;
    if (lane < 32) {
      uint4* dst = eg + ((size_t)T * 8 + h) * 8;
#pragma unroll
      for (int i = 0; i < 8; ++i) {
        dst[i] = make_uint4(__float_as_uint(top[2 * i]) & 16383u, __float_as_uint(wgt[2 * i] * inv),
                            __float_as_uint(top[2 * i + 1]) & 16383u, __float_as_uint(wgt[2 * i + 1] * inv));
      }
    }
  }
}

#define CVT8(w_, hi_) __builtin_amdgcn_cvt_pk_f32_fp8((int)(w_), hi_)
__device__ void phase_peer(const Params& p) {
  const int lane = threadIdx.x & 63;
  const int gw = blockIdx.x * 4 + (threadIdx.x >> 6), nw = gridDim.x * 4;
  const u16* h2 = (const u16*)(p.ws + OFF_RA);
  const char* ub8 = p.ws + OFF_UB + lane * 16;
  const char* vb8 = p.ws + OFF_VB + lane * 16;
  const float* su = (const float*)(p.ws + OFF_UB + (16ull << 20));
  const float* sv = (const float*)(p.ws + OFF_VB + (16ull << 20));
  const uint2* eg = (const uint2*)(p.ws + OFF_RB);
  const float* mod = (const float*)(p.ws + OFF_MOD);
  if (gw >= NT) return;
  uint2 eAn = eg[(size_t)gw * 128 + lane], eBn = eg[(size_t)gw * 128 + 64 + lane];
  u32x4 hAn = *(const u32x4*)(h2 + (size_t)gw * D + lane * 16), hBn = *(const u32x4*)(h2 + (size_t)gw * D + lane * 16 + 8);
  u32x4 ubuf[16], vbuf[16];
#pragma unroll
  for (int k = 0; k < 16; ++k) {
    const int e = __builtin_amdgcn_readlane((int)eAn.x, k);
    ubuf[k] = *(const u32x4*)(ub8 + (size_t)e * 1024);
  }
  for (int T = gw; T < NT; T += nw) {
    const int seq = T >> 14;
    const uint2 eA = eAn, eB = eBn;
    f32x2 hf[8];
    hf[0] = (f32x2){bflo(hAn[0]), bfhi(hAn[0])}; hf[1] = (f32x2){bflo(hAn[1]), bfhi(hAn[1])};
    hf[2] = (f32x2){bflo(hAn[2]), bfhi(hAn[2])}; hf[3] = (f32x2){bflo(hAn[3]), bfhi(hAn[3])};
    hf[4] = (f32x2){bflo(hBn[0]), bfhi(hBn[0])}; hf[5] = (f32x2){bflo(hBn[1]), bfhi(hBn[1])};
    hf[6] = (f32x2){bflo(hBn[2]), bfhi(hBn[2])}; hf[7] = (f32x2){bflo(hBn[3]), bfhi(hBn[3])};
    const float suA = su[eA.x], suB = su[eB.x];
    const float gsA = __uint_as_float(eA.y) * sv[eA.x], gsB = __uint_as_float(eB.y) * sv[eB.x];
    {
      const int Tn = (T + nw < NT) ? T + nw : T;
      eAn = eg[(size_t)Tn * 128 + lane]; eBn = eg[(size_t)Tn * 128 + 64 + lane];
      hAn = *(const u32x4*)(h2 + (size_t)Tn * D + lane * 16); hBn = *(const u32x4*)(h2 + (size_t)Tn * D + lane * 16 + 8);
    }
    f32x2 o[8];
#pragma unroll
    for (int i = 0; i < 8; ++i) o[i] = (f32x2){0.f, 0.f};
#pragma unroll 1
    for (int h = 0; h < 8; ++h) {
      const int ecur = (h < 4) ? (int)eA.x : (int)eB.x;
      const int base = (h & 3) * 16;
#pragma unroll
      for (int k = 0; k < 16; ++k) {
        const int e = __builtin_amdgcn_readlane(ecur, base + k);
        vbuf[k] = *(const u32x4*)(vb8 + (size_t)e * 1024);
      }
      float acc[16];
#pragma unroll
      for (int k = 0; k < 16; ++k) {
        const u32x4 a = ubuf[k];
        f32x2 s2 = hf[0] * CVT8(a[0], false);
        s2 = __builtin_elementwise_fma(hf[1], CVT8(a[0], true), s2);
        s2 = __builtin_elementwise_fma(hf[2], CVT8(a[1], false), s2);
        s2 = __builtin_elementwise_fma(hf[3], CVT8(a[1], true), s2);
        s2 = __builtin_elementwise_fma(hf[4], CVT8(a[2], false), s2);
        s2 = __builtin_elementwise_fma(hf[5], CVT8(a[2], true), s2);
        s2 = __builtin_elementwise_fma(hf[6], CVT8(a[3], false), s2);
        s2 = __builtin_elementwise_fma(hf[7], CVT8(a[3], true), s2);
        acc[k] = s2.x + s2.y;
      }
      {
        const int enx = (h < 3) ? (int)eA.x : ((h < 7) ? (int)eB.x : (int)eAn.x);
        const int base1 = ((h + 1) & 3) * 16;
#pragma unroll
        for (int k = 0; k < 16; ++k) {
          const int e = __builtin_amdgcn_readlane(enx, base1 + k);
          ubuf[k] = *(const u32x4*)(ub8 + (size_t)e * 1024);
        }
      }
      float a8[8], a4[4], a2[2], tot;
      {
        const bool up = (lane & 32) != 0;
#pragma unroll
        for (int i = 0; i < 8; ++i) { float send = up ? acc[i] : acc[i + 8]; float keep = up ? acc[i + 8] : acc[i]; a8[i] = keep + __shfl_xor(send, 32); }
      }
      {
        const bool up = (lane & 16) != 0;
#pragma unroll
        for (int i = 0; i < 4; ++i) { float send = up ? a8[i] : a8[i + 4]; float keep = up ? a8[i + 4] : a8[i]; a4[i] = keep + __shfl_xor(send, 16); }
      }
      {
        const bool up = (lane & 8) != 0;
#pragma unroll
        for (int i = 0; i < 2; ++i) { float send = up ? a4[i] : a4[i + 2]; float keep = up ? a4[i + 2] : a4[i]; a2[i] = keep + __shfl_xor(send, 8); }
      }
      {
        const bool up = (lane & 4) != 0;
        float send = up ? a2[0] : a2[1]; float keep = up ? a2[1] : a2[0]; tot = keep + __shfl_xor(send, 4);
      }
      tot += __shfl_xor(tot, 2);
      tot += __shfl_xor(tot, 1);
      const float sucur = (h < 4) ? suA : suB;
      const float gscur = (h < 4) ? gsA : gsB;
      const float suk = __shfl(sucur, base + (lane >> 2));
      const float gsk = __shfl(gscur, base + (lane >> 2));
      const float coef = gsk * gelu_tanh(suk * tot);
      const int coefb = (int)__float_as_uint(coef);
#pragma unroll
      for (int k = 0; k < 16; ++k) {
        const float ck = __uint_as_float((unsigned)__builtin_amdgcn_readlane(coefb, 4 * k));
        const f32x2 ck2 = (f32x2){ck, ck};
        const u32x4 a = vbuf[k];
        o[0] = __builtin_elementwise_fma(ck2, CVT8(a[0], false), o[0]);
        o[1] = __builtin_elementwise_fma(ck2, CVT8(a[0], true), o[1]);
        o[2] = __builtin_elementwise_fma(ck2, CVT8(a[1], false), o[2]);
        o[3] = __builtin_elementwise_fma(ck2, CVT8(a[1], true), o[3]);
        o[4] = __builtin_elementwise_fma(ck2, CVT8(a[2], false), o[4]);
        o[5] = __builtin_elementwise_fma(ck2, CVT8(a[2], true), o[5]);
        o[6] = __builtin_elementwise_fma(ck2, CVT8(a[3], false), o[6]);
        o[7] = __builtin_elementwise_fma(ck2, CVT8(a[3], true), o[7]);
      }
    }
    float* xo = p.out + (size_t)T * D + lane * 16;
    const float* g2 = mod + seq * 6144 + 5120 + lane * 16;
    const float* nf = p.norm_f_g + lane * 16;
    float4 x2[4]; float ss = 0.f;
#pragma unroll
    for (int i = 0; i < 4; ++i) {
      float4 xa = *(const float4*)(xo + 4 * i), ga = *(const float4*)(g2 + 4 * i);
      x2[i].x = xa.x + ga.x * o[2 * i].x; x2[i].y = xa.y + ga.y * o[2 * i].y;
      x2[i].z = xa.z + ga.z * o[2 * i + 1].x; x2[i].w = xa.w + ga.w * o[2 * i + 1].y;
      ss += x2[i].x * x2[i].x + x2[i].y * x2[i].y + x2[i].z * x2[i].z + x2[i].w * x2[i].w;
    }
    ss = wave_sum(ss);
    const float rstd = rsqrtf(ss * (1.f / 1024.f) + 1e-6f);
#pragma unroll
    for (int i = 0; i < 4; ++i) {
      float4 na = *(const float4*)(nf + 4 * i);
      *(float4*)(xo + 4 * i) = make_float4(x2[i].x * rstd * na.x, x2[i].y * rstd * na.y, x2[i].z * rstd * na.z, x2[i].w * rstd * na.w);
    }
  }
}

constexpr int SMEM_BYTES = (SMEM_LRU > SMEM_GEMM) ? SMEM_LRU : SMEM_GEMM;

__global__ void __launch_bounds__(256, 2) mega(Params p) {
  __shared__ __attribute__((aligned(16))) char smem[SMEM_BYTES];
#define RUN_PHASE(ph_, ...)                                         \
  if (p.phase_lo <= (ph_) && (ph_) < p.phase_hi) {                  \
    __VA_ARGS__;                                                    \
    if ((ph_) + 1 < p.phase_hi) cg::this_grid().sync();             \
  }
  RUN_PHASE(0, phase0(p, smem))
  RUN_PHASE(1, phase_norm<false>(p))
  RUN_PHASE(2, phase_gemm1(p, smem))
  RUN_PHASE(3, phase_fft1(p, smem); phase_lru_local(p, smem))
  RUN_PHASE(4, phase_carry(p); phase_fft3(p, smem))
  RUN_PHASE(5, phase_lru_fix(p))
  RUN_PHASE(6, phase_gemm2(p, smem))
  RUN_PHASE(7, phase_norm<true>(p))
  RUN_PHASE(8, phase_gemm3(p, smem))
  RUN_PHASE(9, phase_topk(p))
  RUN_PHASE(10, phase_peer(p))
}

extern "C" void kernel_launch(void* const* d_in, const int* in_sizes, int n_in, void* d_out, int out_size,
                              void* d_ws, size_t ws_size, hipStream_t stream) {
  static int grid_blocks = 0;
  if (!grid_blocks) {
    int dev = 0, cus = 0, per_cu = 0;
    hipGetDevice(&dev);
    hipDeviceGetAttribute(&cus, hipDeviceAttributeMultiprocessorCount, dev);
    hipOccupancyMaxActiveBlocksPerMultiprocessor(&per_cu, mega, 256, 0);
    if (per_cu < 1) per_cu = 1;
    if (per_cu > 2) per_cu = 2;
    grid_blocks = cus * per_cu;
  }
  if (ws_size < WS_TOTAL) { fprintf(stderr, "workspace too small: %zu < %zu\n", ws_size, (size_t)WS_TOTAL); return; }
  Params p{};
  p.x_prompt = (const float*)d_in[0]; p.x_sample = (const float*)d_in[1]; p.c_prompt = (const float*)d_in[2]; p.c_sample = (const float*)d_in[3];
  p.ada_w = (const float*)d_in[4]; p.ada_b = (const float*)d_in[5]; p.norm1_g = (const float*)d_in[6]; p.w_in = (const float*)d_in[7];
  p.fnet_w = (const float*)d_in[8]; p.conv_w = (const float*)d_in[9]; p.conv_b = (const float*)d_in[10]; p.lru_wa = (const float*)d_in[11];
  p.lru_ba = (const float*)d_in[12]; p.lru_wx = (const float*)d_in[13]; p.lru_bx = (const float*)d_in[14]; p.lru_lambda = (const float*)d_in[15];
  p.w_out = (const float*)d_in[16]; p.norm2_g = (const float*)d_in[17]; p.peer_wq = (const float*)d_in[18]; p.peer_k1 = (const float*)d_in[19];
  p.peer_k2 = (const float*)d_in[20]; p.peer_u = (const float*)d_in[21]; p.peer_v = (const float*)d_in[22]; p.norm_f_g = (const float*)d_in[23];
  p.out = (float*)d_out; p.ws = (char*)d_ws;
#if COOP
  p.phase_lo = 0; p.phase_hi = NPHASE;
  void* args[] = {&p};
  hipError_t e = hipLaunchCooperativeKernel((void*)mega, dim3(grid_blocks), dim3(256), args, 0, stream);
  if (e != hipSuccess) fprintf(stderr, "cooperative launch failed: %s (grid %d)\n", hipGetErrorString(e), grid_blocks);
#else
  for (int ph = 0; ph < NPHASE; ++ph) {
    p.phase_lo = ph; p.phase_hi = ph + 1;
    hipLaunchKernelGGL(mega, dim3(grid_blocks), dim3(256), 0, stream, p);
  }
#endif
}
```

```cpp
#include <hip/hip_runtime.h>
#include <hip/hip_cooperative_groups.h>
#include <cstdio>
#include <cstdint>
namespace cg = cooperative_groups;

#ifndef COOP
#define COOP 1
#endif

typedef unsigned short u16;
typedef __attribute__((ext_vector_type(8))) short bf16x8;
typedef __attribute__((ext_vector_type(4))) short s16x4;
typedef __attribute__((ext_vector_type(4))) float f32x4;
typedef __attribute__((ext_vector_type(16))) float f32x16;
typedef short v4i16_t __attribute__((ext_vector_type(4)));
typedef unsigned int u32x4 __attribute__((ext_vector_type(4)));
typedef float f32x2 __attribute__((ext_vector_type(2)));

constexpr int D = 1024;
constexpr int SEQ = 16384;
constexpr int NSEQ = 3;
constexpr int NT = NSEQ * SEQ;
constexpr int NCH = 256;
constexpr int NPHASE = 11;

constexpr size_t OFF_MOD   = 0;
constexpr size_t OFF_BAR   = 512ull << 10;
constexpr size_t OFF_W1T   = 1ull << 20;
constexpr size_t OFF_W2T   = OFF_W1T + (4ull << 20);
constexpr size_t OFF_WQT   = OFF_W2T + (2ull << 20);
constexpr size_t OFF_K1B   = OFF_WQT + (4ull << 20);
constexpr size_t OFF_K2B   = OFF_K1B + (256ull << 10);
constexpr size_t OFF_WAT   = OFF_K2B + (256ull << 10);
constexpr size_t OFF_A1    = OFF_WAT + (256ull << 10);
constexpr size_t OFF_SUMP  = OFF_A1 + (256ull << 10);
constexpr size_t OFF_SUMH  = OFF_SUMP + (3ull << 20);
constexpr size_t OFF_CARRY = OFF_SUMH + (3ull << 20);
constexpr size_t OFF_MTAB  = OFF_CARRY + (3ull << 20);
constexpr size_t OFF_UB    = OFF_MTAB + (8ull << 20);
constexpr size_t OFF_VB    = OFF_UB + (32ull << 20);
constexpr size_t OFF_RA    = OFF_VB + (32ull << 20);
constexpr size_t OFF_RB    = OFF_RA + (96ull << 20);
constexpr size_t OFF_RC    = OFF_RB + (96ull << 20);
constexpr size_t WS_TOTAL  = OFF_RC + (192ull << 20);

struct Params {
  const float* x_prompt; const float* x_sample; const float* c_prompt; const float* c_sample;
  const float* ada_w; const float* ada_b; const float* norm1_g; const float* w_in; const float* fnet_w;
  const float* conv_w; const float* conv_b; const float* lru_wa; const float* lru_ba; const float* lru_wx;
  const float* lru_bx; const float* lru_lambda; const float* w_out; const float* norm2_g; const float* peer_wq;
  const float* peer_k1; const float* peer_k2; const float* peer_u; const float* peer_v; const float* norm_f_g;
  float* out; char* ws;
  int phase_lo; int phase_hi;
};

__device__ __forceinline__ unsigned f2bf(float f) { unsigned u = __float_as_uint(f); u += 0x7FFFu + ((u >> 16) & 1u); return u >> 16; }
__device__ __forceinline__ unsigned pack2(float a, float b) { return f2bf(a) | (f2bf(b) << 16); }
__device__ __forceinline__ float bflo(unsigned u) { return __uint_as_float(u << 16); }
__device__ __forceinline__ float bfhi(unsigned u) { return __uint_as_float(u & 0xFFFF0000u); }
__device__ __forceinline__ float sigmoidf_(float x) { return 1.f / (1.f + __expf(-x)); }
__device__ __forceinline__ float gelu_tanh(float x) {
  float y = 0.7978845608028654f * (x + 0.044715f * x * x * x);
  return x / (1.f + __expf(-2.f * y));
}
__device__ __forceinline__ float wave_sum(float v) {
#pragma unroll
  for (int o = 32; o > 0; o >>= 1) v += __shfl_xor(v, o);
  return v;
}
__device__ __forceinline__ const float* xrow(const Params& p, int T) {
  return (T < 2 * SEQ) ? p.x_prompt + (size_t)T * D : p.x_sample + (size_t)(T - 2 * SEQ) * D;
}

constexpr int BK = 64;
constexpr int LDSA = BK + 8;
constexpr int LDSB_NN = 128 + 8;
constexpr int SMEM_GEMM = 2 * 128 * LDSA * 2;

template <int BMODE, class ARow, class BRow, class Epi>
__device__ __forceinline__ void gemm_tile(ARow arow, BRow brow, int K, Epi epi, char* smem) {
  u16* sA = (u16*)smem;
  u16* sB = sA + 128 * LDSA;
  const int tid = threadIdx.x, lane = tid & 63, w = tid >> 6;
  const int wm = w >> 1, wn = w & 1;
  f32x4 acc[4][4];
#pragma unroll
  for (int i = 0; i < 4; ++i)
#pragma unroll
    for (int j = 0; j < 4; ++j) acc[i][j] = (f32x4){0.f, 0.f, 0.f, 0.f};

  const u16* pa[4];
  const u16* pb[4];
#pragma unroll
  for (int i = 0; i < 4; ++i) {
    int c = tid + 256 * i;
    pa[i] = arow(c >> 3) + (c & 7) * 8;
    if (BMODE == 0) pb[i] = brow(c >> 3) + (c & 7) * 8;
  }
  u32x4 ra[4], rb[4];
#define GLOAD(k0_)                                                                                       \
  _Pragma("unroll") for (int i = 0; i < 4; ++i) {                                                        \
    ra[i] = *(const u32x4*)(pa[i] + (k0_));                                                              \
    if (BMODE == 0) rb[i] = *(const u32x4*)(pb[i] + (k0_));                                              \
    else { int c = tid + 256 * i; rb[i] = *(const u32x4*)(brow((k0_) + (c >> 4)) + (c & 15) * 8); }      \
  }
  GLOAD(0)
  for (int k0 = 0; k0 < K; k0 += BK) {
    __syncthreads();
#pragma unroll
    for (int i = 0; i < 4; ++i) {
      int c = tid + 256 * i;
      *(u32x4*)(sA + (c >> 3) * LDSA + (c & 7) * 8) = ra[i];
      if (BMODE == 0) *(u32x4*)(sB + (c >> 3) * LDSA + (c & 7) * 8) = rb[i];
      else *(u32x4*)(sB + (c >> 4) * LDSB_NN + (c & 15) * 8) = rb[i];
    }
    __syncthreads();
    if (k0 + BK < K) { GLOAD(k0 + BK) }
#pragma unroll 1
    for (int kk = 0; kk < 2; ++kk) {
      bf16x8 af[4], bfr[4];
#pragma unroll
      for (int mt = 0; mt < 4; ++mt)
        af[mt] = *(const bf16x8*)(sA + (wm * 64 + mt * 16 + (lane & 15)) * LDSA + kk * 32 + (lane >> 4) * 8);
#pragma unroll
      for (int nt = 0; nt < 4; ++nt) {
        if (BMODE == 0) {
          bfr[nt] = *(const bf16x8*)(sB + (wn * 64 + nt * 16 + (lane & 15)) * LDSA + kk * 32 + (lane >> 4) * 8);
        } else {
          int g = lane >> 4, i16 = lane & 15, q = i16 >> 2, pq = i16 & 3;
          const u16* ad = sB + (kk * 32 + 8 * g + q) * LDSB_NN + wn * 64 + nt * 16 + 4 * pq;
          v4i16_t lo = __builtin_amdgcn_ds_read_tr16_b64_v4i16((__attribute__((address_space(3))) v4i16_t*)(ad));
          v4i16_t hi = __builtin_amdgcn_ds_read_tr16_b64_v4i16((__attribute__((address_space(3))) v4i16_t*)(ad + 4 * LDSB_NN));
          bfr[nt] = (bf16x8){lo[0], lo[1], lo[2], lo[3], hi[0], hi[1], hi[2], hi[3]};
        }
      }
#pragma unroll
      for (int mt = 0; mt < 4; ++mt)
#pragma unroll
        for (int nt = 0; nt < 4; ++nt)
          acc[mt][nt] = __builtin_amdgcn_mfma_f32_16x16x32_bf16(af[mt], bfr[nt], acc[mt][nt], 0, 0, 0);
    }
  }
#pragma unroll
  for (int mt = 0; mt < 4; ++mt)
#pragma unroll
    for (int nt = 0; nt < 4; ++nt)
#pragma unroll
      for (int j = 0; j < 4; ++j)
        epi(wm * 64 + mt * 16 + (lane >> 4) * 4 + j, wn * 64 + nt * 16 + (lane & 15), acc[mt][nt][j]);
}

__device__ void phase0(const Params& p, char* smem) {
  const int tid = threadIdx.x, nb = gridDim.x, bid = blockIdx.x;
  float* sf = (float*)smem;
  float* mod = (float*)(p.ws + OFF_MOD);
  for (int item = bid; item < 96; item += nb) {
    int col = item * 64 + (tid & 63), ks = tid >> 6;
    float a0 = 0.f, a1 = 0.f, a2 = 0.f;
    for (int k = ks * 256; k < ks * 256 + 256; ++k) {
      float wv = p.ada_w[(size_t)k * 6144 + col];
      float c0 = p.c_prompt[k], c1 = p.c_prompt[1024 + k], c2 = p.c_sample[k];
      a0 += c0 * sigmoidf_(c0) * wv; a1 += c1 * sigmoidf_(c1) * wv; a2 += c2 * sigmoidf_(c2) * wv;
    }
    __syncthreads();
    sf[tid * 3 + 0] = a0; sf[tid * 3 + 1] = a1; sf[tid * 3 + 2] = a2;
    __syncthreads();
    if (tid < 64) {
      float bsum = p.ada_b[col];
#pragma unroll
      for (int s = 0; s < 3; ++s) {
        float v = sf[tid * 3 + s] + sf[(tid + 64) * 3 + s] + sf[(tid + 128) * 3 + s] + sf[(tid + 192) * 3 + s];
        mod[s * 6144 + col] = v + bsum;
      }
    }
  }
  __syncthreads();
  float* ct = sf + 1024; float* st = sf + 1024 + 64;
  if (tid < 64) { ct[tid] = cospif(tid / 32.f); st[tid] = sinpif(tid / 32.f); }
  __syncthreads();
  const size_t gtid = (size_t)bid * 256 + tid, gstride = (size_t)nb * 256;
  {
    u16* w1T = (u16*)(p.ws + OFF_W1T);
    for (size_t idx = gtid; idx < 2048ull * 1024; idx += gstride) {
      int n = (int)(idx >> 10), k = (int)(idx & 1023);
      float v;
      if (n < 1024) {
        int comp = n >> 9, g = (n >> 6) & 7, kk = n & 63;
        const float* src = p.w_in + (size_t)k * 1536 + g * 64;
        float s = 0.f;
        for (int c = 0; c < 64; ++c) {
          int j = (c * kk) & 63;
          float tw = comp ? -st[j] : ct[j];
          s += src[c] * tw;
        }
        v = s;
      } else {
        v = p.w_in[(size_t)k * 1536 + (n - 512)];
      }
      w1T[idx] = (u16)f2bf(v);
    }
  }
  {
    u16* w2T = (u16*)(p.ws + OFF_W2T);
    for (size_t idx = gtid; idx < 1024ull * 1024; idx += gstride) {
      int n = (int)(idx >> 10), k = (int)(idx & 1023);
      float v;
      if (k < 512) {
        int g = k >> 6;
        const float* fw = p.fnet_w + (size_t)k * 64;
        const float* wo = p.w_out + (size_t)(g * 64) * 1024 + n;
        float s = 0.f;
        for (int d = 0; d < 64; ++d) s += fw[d] * wo[(size_t)d * 1024];
        v = s * (1.f / 1024.f);
      } else {
        v = p.w_out[(size_t)k * 1024 + n];
      }
      w2T[idx] = (u16)f2bf(v);
    }
  }
  {
    u16* wqT = (u16*)(p.ws + OFF_WQT);
    for (size_t idx = gtid; idx < 2048ull * 1024; idx += gstride) {
      int n = (int)(idx >> 10), k = (int)(idx & 1023);
      wqT[idx] = (u16)f2bf(p.peer_wq[(size_t)k * 2048 + n]);
    }
  }
  {
    u16* k1b = (u16*)(p.ws + OFF_K1B); u16* k2b = (u16*)(p.ws + OFF_K2B);
    for (size_t idx = gtid; idx < 131072; idx += gstride) { k1b[idx] = (u16)f2bf(p.peer_k1[idx]); k2b[idx] = (u16)f2bf(p.peer_k2[idx]); }
  }
  {
    u16* waT = (u16*)(p.ws + OFF_WAT);
    for (size_t idx = gtid; idx < 131072; idx += gstride) {
      int i = idx & 63, j = (idx >> 6) & 63, h = (idx >> 12) & 7, gate = (idx >> 15) & 1, d = (int)(idx >> 16);
      const float* src = gate ? p.lru_wx : p.lru_wa;
      waT[idx] = (u16)f2bf(src[((size_t)(d * 8 + h) * 64 + i) * 64 + j]);
    }
  }
  {
    u16* A1 = (u16*)(p.ws + OFF_A1);
    for (size_t idx = gtid; idx < 65536; idx += gstride) {
      int m = (int)(idx >> 8), k = (int)(idx & 255);
      int cp = m >> 7, k1 = m & 127, comp = k >> 7, s1 = k & 127;
      int j = (k1 * s1) & 127;
      float C = cospif(j / 64.f), S = sinpif(j / 64.f);
      float v = (cp == comp) ? C : (cp == 0 ? S : -S);
      A1[idx] = (u16)f2bf(v);
    }
    u16* Mt = (u16*)(p.ws + OFF_MTAB);
    for (size_t idx = gtid; idx < 128ull * 128 * 256; idx += gstride) {
      int k = (int)(idx & 255), k2 = (int)((idx >> 8) & 127), k1 = (int)(idx >> 15);
      int comp = k >> 7, s2 = k & 127;
      int j = (s2 * (k1 + 128 * k2)) & 16383;
      float v = comp ? sinpif(j / 8192.f) : cospif(j / 8192.f);
      Mt[idx] = (u16)f2bf(v);
    }
  }
  {
    const int lane = tid & 63;
    const int gwv = bid * 4 + (tid >> 6), nwv = nb * 4;
    for (int row = gwv; row < 32768; row += nwv) {
      const int tbl = row >> 14, e = row & 16383;
      const float* src = (tbl ? p.peer_v : p.peer_u) + (size_t)e * D + lane * 16;
      float4 f0 = *(const float4*)src, f1 = *(const float4*)(src + 4), f2 = *(const float4*)(src + 8), f3 = *(const float4*)(src + 12);
      float m = fmaxf(fmaxf(fmaxf(fabsf(f0.x), fabsf(f0.y)), fmaxf(fabsf(f0.z), fabsf(f0.w))), fmaxf(fmaxf(fabsf(f1.x), fabsf(f1.y)), fmaxf(fabsf(f1.z), fabsf(f1.w))));
      m = fmaxf(m, fmaxf(fmaxf(fmaxf(fabsf(f2.x), fabsf(f2.y)), fmaxf(fabsf(f2.z), fabsf(f2.w))), fmaxf(fmaxf(fabsf(f3.x), fabsf(f3.y)), fmaxf(fabsf(f3.z), fabsf(f3.w)))));
#pragma unroll
      for (int o = 32; o > 0; o >>= 1) m = fmaxf(m, __shfl_xor(m, o));
      const float inv = (m > 0.f) ? 224.f / m : 0.f;
      const float scl = (m > 0.f) ? m * (1.f / 224.f) : 0.f;
      int d0 = __builtin_amdgcn_cvt_pk_fp8_f32(f0.x * inv, f0.y * inv, 0, false); d0 = __builtin_amdgcn_cvt_pk_fp8_f32(f0.z * inv, f0.w * inv, d0, true);
      int d1 = __builtin_amdgcn_cvt_pk_fp8_f32(f1.x * inv, f1.y * inv, 0, false); d1 = __builtin_amdgcn_cvt_pk_fp8_f32(f1.z * inv, f1.w * inv, d1, true);
      int d2 = __builtin_amdgcn_cvt_pk_fp8_f32(f2.x * inv, f2.y * inv, 0, false); d2 = __builtin_amdgcn_cvt_pk_fp8_f32(f2.z * inv, f2.w * inv, d2, true);
      int d3 = __builtin_amdgcn_cvt_pk_fp8_f32(f3.x * inv, f3.y * inv, 0, false); d3 = __builtin_amdgcn_cvt_pk_fp8_f32(f3.z * inv, f3.w * inv, d3, true);
      char* dst = p.ws + (tbl ? OFF_VB : OFF_UB);
      *(uint4*)(dst + (size_t)e * 1024 + lane * 16) = make_uint4((unsigned)d0, (unsigned)d1, (unsigned)d2, (unsigned)d3);
      if (lane == 0) ((float*)(dst + (16ull << 20)))[e] = scl;
    }
  }
}

template <bool SECOND>
__device__ void phase_norm(const Params& p) {
  const int lane = threadIdx.x & 63;
  const int gw = blockIdx.x * 4 + (threadIdx.x >> 6), nw = gridDim.x * 4;
  const float* mod = (const float*)(p.ws + OFF_MOD);
  const float* gain = SECOND ? p.norm2_g : p.norm1_g;
  u16* dst = (u16*)(p.ws + OFF_RA);
  for (int T = gw; T < NT; T += nw) {
    const float* xr = SECOND ? (p.out + (size_t)T * D) : xrow(p, T);
    const int seq = T >> 14;
    const float* sh = mod + seq * 6144 + (SECOND ? 3072 : 0);
    const float* sc = mod + seq * 6144 + (SECOND ? 4096 : 1024);
    float4 v[4]; float ss = 0.f;
#pragma unroll
    for (int i = 0; i < 4; ++i) {
      v[i] = ((const float4*)xr)[lane + 64 * i];
      ss += v[i].x * v[i].x + v[i].y * v[i].y + v[i].z * v[i].z + v[i].w * v[i].w;
    }
    ss = wave_sum(ss);
    float rstd = rsqrtf(ss * (1.f / 1024.f) + 1e-6f);
#pragma unroll
    for (int i = 0; i < 4; ++i) {
      int col = 4 * (lane + 64 * i);
      float4 g = *(const float4*)(gain + col), s1 = *(const float4*)(sc + col), s0 = *(const float4*)(sh + col);
      float y0 = v[i].x * rstd * g.x * (1.f + s1.x) + s0.x;
      float y1 = v[i].y * rstd * g.y * (1.f + s1.y) + s0.y;
      float y2 = v[i].z * rstd * g.z * (1.f + s1.z) + s0.z;
      float y3 = v[i].w * rstd * g.w * (1.f + s1.w) + s0.w;
      *(uint2*)(dst + (size_t)T * D + col) = make_uint2(pack2(y0, y1), pack2(y2, y3));
    }
  }
}

__device__ void phase_gemm1(const Params& p, char* smem) {
  const u16* h1 = (const u16*)(p.ws + OFF_RA);
  const u16* w1T = (const u16*)(p.ws + OFF_W1T);
  u16* Z = (u16*)(p.ws + OFF_RB);
  u16* ux = (u16*)(p.ws + OFF_RC);
  u16* gg = ux + (size_t)NT * 512;
  for (int tile = blockIdx.x; tile < 384 * 16; tile += gridDim.x) {
    const int mt = tile >> 4, nt = tile & 15;
    const int T0 = mt * 128, n0 = nt * 128;
    auto arow = [&](int r) { return h1 + (size_t)(T0 + r) * D; };
    auto brow = [&](int r) { return w1T + (size_t)(n0 + r) * D; };
    if (nt < 8) {
      gemm_tile<0>(arow, brow, D, [&](int r, int c, float v) { Z[(size_t)(T0 + r) * 1024 + n0 + c] = (u16)f2bf(v); }, smem);
    } else if (nt < 12) {
      gemm_tile<0>(arow, brow, D, [&](int r, int c, float v) { ux[(size_t)(T0 + r) * 512 + (n0 - 1024) + c] = (u16)f2bf(v); }, smem);
    } else {
      gemm_tile<0>(arow, brow, D, [&](int r, int c, float v) { gg[(size_t)(T0 + r) * 512 + (n0 - 1536) + c] = (u16)f2bf(gelu_tanh(v)); }, smem);
    }
  }
}

__device__ void phase_fft1(const Params& p, char* smem) {
  const u16* Z = (const u16*)(p.ws + OFF_RB);
  const u16* A1 = (const u16*)(p.ws + OFF_A1);
  u16* Tb = (u16*)(p.ws + OFF_RA);
  for (int tile = blockIdx.x; tile < 3072; tile += gridDim.x) {
    const int mtile = tile & 1, chb = (tile >> 1) & 3, s2 = (tile >> 3) & 127, b = tile >> 10;
    const u16* Zb = Z + ((size_t)b * SEQ + s2) * 1024 + chb * 128;
    auto arow = [&](int r) { return A1 + (size_t)(mtile * 128 + r) * 256; };
    auto brow = [&](int k) { return Zb + (size_t)(k & 127) * (128 * 1024) + (k >> 7) * 512; };
    u16* To = Tb + (((size_t)b * 128) * 128 + s2) * 1024 + mtile * 512 + chb * 128;
    gemm_tile<1>(arow, brow, 256, [&](int r, int c, float v) { To[(size_t)r * (128 * 1024) + c] = (u16)f2bf(v); }, smem);
  }
}

constexpr int XP = 68;
constexpr int SMEM_LRU = 64 * XP * 4 + 2 * 64 * 64 * 4;
__device__ void phase_lru_local(const Params& p, char* smem) {
  float* sX = (float*)smem;
  float* sAa = sX + 64 * XP;
  float* sBb = sAa + 64 * 64;
  u16* stg = (u16*)sAa;
  const int tid = threadIdx.x, lane = tid & 63, w = tid >> 6;
  const u16* ux = (const u16*)(p.ws + OFF_RC);
  const u16* waT = (const u16*)(p.ws + OFF_WAT);
  float* sumP = (float*)(p.ws + OFF_SUMP);
  float* sumH = (float*)(p.ws + OFF_SUMH);
  u16* HP = (u16*)p.out;
  for (int tile = blockIdx.x; tile < NSEQ * NCH * 8; tile += gridDim.x) {
    const int h = tile & 7, c = (tile >> 3) & (NCH - 1), b = tile >> 11;
    const int T0 = b * SEQ + c * 64;
    __syncthreads();
    for (int idx = tid; idx < 67 * 8; idx += 256) {
      int r = idx >> 3, c8 = idx & 7;
      int t = c * 64 - 2 + r;
      uint4 v = make_uint4(0, 0, 0, 0);
      if (t >= 0 && t < SEQ) v = *(const uint4*)(ux + ((size_t)b * SEQ + t) * 512 + h * 64 + c8 * 8);
      *(uint4*)(stg + r * 64 + c8 * 8) = v;
    }
    __syncthreads();
    {
      const int ch = tid & 63, chg = h * 64 + ch;
      const float w0 = p.conv_w[chg], w1 = p.conv_w[512 + chg], w2 = p.conv_w[1024 + chg], w3 = p.conv_w[1536 + chg];
      const float cb = p.conv_b[chg];
#pragma unroll 4
      for (int i = 0; i < 16; ++i) {
        int t = (tid >> 6) + 4 * i;
        float v = cb + w0 * __uint_as_float((unsigned)stg[t * 64 + ch] << 16) + w1 * __uint_as_float((unsigned)stg[(t + 1) * 64 + ch] << 16)
                + w2 * __uint_as_float((unsigned)stg[(t + 2) * 64 + ch] << 16) + w3 * __uint_as_float((unsigned)stg[(t + 3) * 64 + ch] << 16);
        sX[t * XP + ch] = v;
      }
    }
    __syncthreads();
    bf16x8 af[2];
#pragma unroll
    for (int kk = 0; kk < 2; ++kk) {
      const float* src = sX + (16 * w + (lane & 15)) * XP + kk * 32 + (lane >> 4) * 8;
      float4 f0 = *(const float4*)src, f1 = *(const float4*)(src + 4);
      af[kk] = (bf16x8){(short)f2bf(f0.x), (short)f2bf(f0.y), (short)f2bf(f0.z), (short)f2bf(f0.w),
                        (short)f2bf(f1.x), (short)f2bf(f1.y), (short)f2bf(f1.z), (short)f2bf(f1.w)};
    }
    for (int d = 0; d < 2; ++d) {
      f32x4 acc[2][4];
#pragma unroll
      for (int g = 0; g < 2; ++g)
#pragma unroll
        for (int nt = 0; nt < 4; ++nt) {
          acc[g][nt] = (f32x4){0.f, 0.f, 0.f, 0.f};
#pragma unroll
          for (int kk = 0; kk < 2; ++kk) {
            const u16* bp = waT + ((size_t)((d * 2 + g) * 8 + h) * 64 + nt * 16 + (lane & 15)) * 64 + kk * 32 + (lane >> 4) * 8;
            bf16x8 bfr = *(const bf16x8*)bp;
            acc[g][nt] = __builtin_amdgcn_mfma_f32_16x16x32_bf16(af[kk], bfr, acc[g][nt], 0, 0, 0);
          }
        }
#pragma unroll
      for (int nt = 0; nt < 4; ++nt) {
        const int ch = nt * 16 + (lane & 15), chg = h * 64 + ch;
        const float ba = p.lru_ba[d * 512 + chg], bx = p.lru_bx[d * 512 + chg];
        const float lam = p.lru_lambda[d * 512 + chg];
        const float cl = -8.f * log1pf(expf(-lam));
#pragma unroll
        for (int j = 0; j < 4; ++j) {
          const int tok = 16 * w + 4 * (lane >> 4) + j;
          float r = sigmoidf_(acc[0][nt][j] + ba);
          float ii = sigmoidf_(acc[1][nt][j] + bx);
          float la = cl * r;
          float a = expf(la);
          float bb = sqrtf(-expm1f(2.f * la)) * ii * sX[tok * XP + ch];
          sAa[tok * 64 + ch] = a; sBb[tok * 64 + ch] = bb;
        }
      }
      __syncthreads();
      if (tid < 64) {
        const int ch = tid;
        float hh = 0.f, P = 1.f;
        if (d == 0) {
          for (int t = 0; t < 64; ++t) {
            float a = sAa[t * 64 + ch], bb = sBb[t * 64 + ch];
            hh = a * hh + bb; P *= a;
            sBb[t * 64 + ch] = hh; sAa[t * 64 + ch] = P;
          }
        } else {
          for (int t = 63; t >= 0; --t) {
            float a = sAa[t * 64 + ch], bb = sBb[t * 64 + ch];
            hh = a * hh + bb; P *= a;
            sBb[t * 64 + ch] = hh; sAa[t * 64 + ch] = P;
          }
        }
        size_t si = ((size_t)(b * NCH + c) * 2 + d) * 512 + h * 64 + ch;
        sumP[si] = P; sumH[si] = hh;
      }
      __syncthreads();
      u16* Hd = HP + (size_t)(d * 2 + 0) * NT * 512;
      u16* Pd = HP + (size_t)(d * 2 + 1) * NT * 512;
#pragma unroll
      for (int i = 0; i < 2; ++i) {
        int idx = tid + 256 * i; int t = idx >> 3, c8 = idx & 7;
        const float* hs = sBb + t * 64 + c8 * 8; const float* ps = sAa + t * 64 + c8 * 8;
        size_t o = (size_t)(T0 + t) * 512 + h * 64 + c8 * 8;
        *(uint4*)(Hd + o) = make_uint4(pack2(hs[0], hs[1]), pack2(hs[2], hs[3]), pack2(hs[4], hs[5]), pack2(hs[6], hs[7]));
        *(uint4*)(Pd + o) = make_uint4(pack2(ps[0], ps[1]), pack2(ps[2], ps[3]), pack2(ps[4], ps[5]), pack2(ps[6], ps[7]));
      }
      __syncthreads();
    }
  }
}

__device__ void phase_carry(const Params& p) {
  const float* sumP = (const float*)(p.ws + OFF_SUMP);
  const float* sumH = (const float*)(p.ws + OFF_SUMH);
  float* carry = (float*)(p.ws + OFF_CARRY);
  const int gid = blockIdx.x * 256 + threadIdx.x;
  if (gid >= NSEQ * 2 * 512) return;
  const int chg = gid & 511, d = (gid >> 9) & 1, b = gid >> 10;
  float cin = 0.f;
  if (d == 0) {
#pragma unroll 2
    for (int c = 0; c < NCH; ++c) {
      size_t si = ((size_t)(b * NCH + c) * 2 + d) * 512 + chg;
      float P = sumP[si], H = sumH[si];
      carry[si] = cin; cin = P * cin + H;
    }
  } else {
#pragma unroll 2
    for (int c = NCH - 1; c >= 0; --c) {
      size_t si = ((size_t)(b * NCH + c) * 2 + d) * 512 + chg;
      float P = sumP[si], H = sumH[si];
      carry[si] = cin; cin = P * cin + H;
    }
  }
}

__device__ void phase_fft3(const Params& p, char* smem) {
  const u16* Tb = (const u16*)(p.ws + OFF_RA);
  const u16* Mt = (const u16*)(p.ws + OFF_MTAB);
  u16* Y = (u16*)(p.ws + OFF_RB);
  for (int tile = blockIdx.x; tile < 1536; tile += gridDim.x) {
    const int chb = tile & 3, k1 = (tile >> 2) & 127, b = tile >> 9;
    const u16* Tk = Tb + ((size_t)(b * 128 + k1) * 128) * 1024 + chb * 128;
    auto arow = [&](int r) { return Mt + ((size_t)k1 * 128 + r) * 256; };
    auto brow = [&](int k) { return Tk + (size_t)(k & 127) * 1024 + (k >> 7) * 512; };
    u16* Yo = Y + ((size_t)b * SEQ + k1) * 1024 + chb * 128;
    gemm_tile<1>(arow, brow, 256, [&](int r, int c, float v) { Yo[(size_t)r * (128 * 1024) + c] = (u16)f2bf(v); }, smem);
  }
}

__device__ void phase_lru_fix(const Params& p) {
  const u16* HP = (const u16*)p.out;
  const u16* gg = (const u16*)(p.ws + OFF_RC) + (size_t)NT * 512;
  const float* carry = (const float*)(p.ws + OFF_CARRY);
  u16* Y = (u16*)(p.ws + OFF_RB);
  const size_t gtid = (size_t)blockIdx.x * 256 + threadIdx.x, gstride = (size_t)gridDim.x * 256;
  for (size_t idx = gtid; idx < (size_t)NT * 64; idx += gstride) {
    const int T = (int)(idx >> 6), ch0 = (int)(idx & 63) * 8;
    const int b = T >> 14, c = (T & (SEQ - 1)) >> 6;
    const size_t o = (size_t)T * 512 + ch0;
    uint4 hf = *(const uint4*)(HP + o), pf = *(const uint4*)(HP + (size_t)NT * 512 + o);
    uint4 hr = *(const uint4*)(HP + (size_t)2 * NT * 512 + o), pr = *(const uint4*)(HP + (size_t)3 * NT * 512 + o);
    uint4 g = *(const uint4*)(gg + o);
    const float* cf = carry + ((size_t)(b * NCH + c) * 2 + 0) * 512 + ch0;
    const float* cr = carry + ((size_t)(b * NCH + c) * 2 + 1) * 512 + ch0;
    float4 cf0 = *(const float4*)cf, cf1 = *(const float4*)(cf + 4), cr0 = *(const float4*)cr, cr1 = *(const float4*)(cr + 4);
    float y0 = (bflo(hf.x) + bflo(pf.x) * cf0.x + bflo(hr.x) + bflo(pr.x) * cr0.x) * bflo(g.x);
    float y1 = (bfhi(hf.x) + bfhi(pf.x) * cf0.y + bfhi(hr.x) + bfhi(pr.x) * cr0.y) * bfhi(g.x);
    float y2 = (bflo(hf.y) + bflo(pf.y) * cf0.z + bflo(hr.y) + bflo(pr.y) * cr0.z) * bflo(g.y);
    float y3 = (bfhi(hf.y) + bfhi(pf.y) * cf0.w + bfhi(hr.y) + bfhi(pr.y) * cr0.w) * bfhi(g.y);
    float y4 = (bflo(hf.z) + bflo(pf.z) * cf1.x + bflo(hr.z) + bflo(pr.z) * cr1.x) * bflo(g.z);
    float y5 = (bfhi(hf.z) + bfhi(pf.z) * cf1.y + bfhi(hr.z) + bfhi(pr.z) * cr1.y) * bfhi(g.z);
    float y6 = (bflo(hf.w) + bflo(pf.w) * cf1.z + bflo(hr.w) + bflo(pr.w) * cr1.z) * bflo(g.w);
    float y7 = (bfhi(hf.w) + bfhi(pf.w) * cf1.w + bfhi(hr.w) + bfhi(pr.w) * cr1.w) * bfhi(g.w);
    *(uint4*)(Y + (size_t)T * 1024 + 512 + ch0) = make_uint4(pack2(y0, y1), pack2(y2, y3), pack2(y4, y5), pack2(y6, y7));
  }
}

__device__ void phase_gemm2(const Params& p, char* smem) {
  const u16* Y = (const u16*)(p.ws + OFF_RB);
  const u16* w2T = (const u16*)(p.ws + OFF_W2T);
  const float* mod = (const float*)(p.ws + OFF_MOD);
  for (int tile = blockIdx.x; tile < 384 * 8; tile += gridDim.x) {
    const int mt = tile >> 3, nt = tile & 7;
    const int T0 = mt * 128, n0 = nt * 128;
    const int seq = T0 >> 14;
    const float* g1 = mod + seq * 6144 + 2048 + n0;
    auto arow = [&](int r) { return Y + (size_t)(T0 + r) * D; };
    auto brow = [&](int r) { return w2T + (size_t)(n0 + r) * D; };
    gemm_tile<0>(arow, brow, D, [&](int r, int c, float v) {
      const float* xr = xrow(p, T0 + r);
      p.out[(size_t)(T0 + r) * D + n0 + c] = xr[n0 + c] + g1[c] * v;
    }, smem);
  }
}

__device__ void phase_gemm3(const Params& p, char* smem) {
  const u16* h2 = (const u16*)(p.ws + OFF_RA);
  const u16* wqT = (const u16*)(p.ws + OFF_WQT);
  u16* q = (u16*)(p.ws + OFF_RC);
  for (int tile = blockIdx.x; tile < 384 * 16; tile += gridDim.x) {
    const int mt = tile >> 4, nt = tile & 15;
    const int T0 = mt * 128, n0 = nt * 128;
    auto arow = [&](int r) { return h2 + (size_t)(T0 + r) * D; };
    auto brow = [&](int r) { return wqT + (size_t)(n0 + r) * D; };
    gemm_tile<0>(arow, brow, D, [&](int r, int c, float v) { q[(size_t)(T0 + r) * 2048 + n0 + c] = (u16)f2bf(v); }, smem);
  }
}

template <int N>
__device__ __forceinline__ void bitonic_sort_desc(float (&v)[N]) {
#pragma unroll
  for (int k = 2; k <= N; k <<= 1) {
#pragma unroll
    for (int j = k >> 1; j > 0; j >>= 1) {
#pragma unroll
      for (int i = 0; i < N; ++i) {
        const int l = i ^ j;
        if (l > i) {
          const bool desc = ((i & k) == 0);
          float mx = fmaxf(v[i], v[l]), mn = fminf(v[i], v[l]);
          v[i] = desc ? mx : mn; v[l] = desc ? mn : mx;
        }
      }
    }
  }
}
template <int N>
__device__ __forceinline__ void bitonic_merge_desc(float (&v)[N]) {
#pragma unroll
  for (int j = N >> 1; j > 0; j >>= 1) {
#pragma unroll
    for (int i = 0; i < N; ++i) {
      const int l = i ^ j;
      if (l > i) { float mx = fmaxf(v[i], v[l]), mn = fminf(v[i], v[l]); v[i] = mx; v[l] = mn; }
    }
  }
}
__device__ __forceinline__ void top16_of_64(const float (&v)[64], float (&top)[16]) {
#pragma unroll
  for (int i = 0; i < 16; ++i) top[i] = v[i];
  bitonic_sort_desc<16>(top);
#pragma unroll
  for (int g = 1; g < 4; ++g) {
    float blk[16];
#pragma unroll
    for (int i = 0; i < 16; ++i) blk[i] = v[16 * g + i];
    bitonic_sort_desc<16>(blk);
#pragma unroll
    for (int i = 0; i < 16; ++i) top[i] = fmaxf(top[i], blk[15 - i]);
    bitonic_merge_desc<16>(top);
  }
}

__device__ __forceinline__ void score_top16(const u16* __restrict__ kb, const u16* __restrict__ qp, int lane, float (&top)[16]) {
  f32x16 acc[4];
#pragma unroll
  for (int mt = 0; mt < 4; ++mt)
#pragma unroll
    for (int r = 0; r < 16; ++r) acc[mt][r] = 0.f;
#pragma unroll 2
  for (int ks = 0; ks < 8; ++ks) {
    bf16x8 bq = *(const bf16x8*)(qp + ks * 16);
#pragma unroll
    for (int mt = 0; mt < 4; ++mt) {
      bf16x8 ak = *(const bf16x8*)(kb + (size_t)(mt * 32 + (lane & 31)) * 128 + ks * 16 + (lane >> 5) * 8);
      acc[mt] = __builtin_amdgcn_mfma_f32_32x32x16_bf16(ak, bq, acc[mt], 0, 0, 0);
    }
  }
  float v[64];
  const int hi = lane >> 5;
#pragma unroll
  for (int mt = 0; mt < 4; ++mt)
#pragma unroll
    for (int r = 0; r < 16; ++r) {
      const unsigned key = 32 * mt + (r & 3) + 8 * (r >> 2) + 4 * hi;
      v[mt * 16 + r] = __uint_as_float((__float_as_uint(acc[mt][r]) & ~127u) | key);
    }
  top16_of_64(v, top);
  float t[16];
#pragma unroll
  for (int i = 0; i < 16; ++i) t[i] = __shfl_xor(top[i], 32);
#pragma unroll
  for (int i = 0; i < 16; ++i) top[i] = fmaxf(top[i], t[15 - i]);
  bitonic_merge_desc<16>(top);
}

__device__ void phase_topk(const Params& p) {
  const int lane = threadIdx.x & 63;
  const int gw = blockIdx.x * 4 + (threadIdx.x >> 6), nw = gridDim.x * 4;
  const u16* q = (const u16*)(p.ws + OFF_RC);
  const u16* k1b = (const u16*)(p.ws + OFF_K1B);
  const u16* k2b = (const u16*)(p.ws + OFF_K2B);
  uint4* eg = (uint4*)(p.ws + OFF_RB);
  for (int item = gw; item < (NT / 32) * 8; item += nw) {
    const int h = item & 7, grp = item >> 3;
    const int T = grp * 32 + (lane & 31);
    const u16* qp = q + (size_t)T * 2048 + h * 256 + (lane >> 5) * 8;
    float t1[16], t2[16];
    score_top16(k1b + (size_t)h * 16384, qp, lane, t1);
    score_top16(k2b + (size_t)h * 16384, qp + 128, lane, t2);
    float cand[64];
#pragma unroll
    for (int i = 0; i < 64; ++i) cand[i] = -3.0e38f;
    {
      int n = 0;
#pragma unroll
      for (int a = 0; a < 16; ++a) {
#pragma unroll
        for (int bb = 0; bb < 16; ++bb) {
          if ((a + 1) * (bb + 1) <= 16) {
            unsigned ia = __float_as_uint(t1[a]) & 127u, ib = __float_as_uint(t2[bb]) & 127u;
            float s = t1[a] + t2[bb];
            cand[n] = __uint_as_float((__float_as_uint(s) & ~16383u) | (ia << 7) | ib);
            ++n;
          }
        }
      }
    }
    float top[16];
    top16_of_64(cand, top);
    float wgt[16]; float mx, sum = 0.f;
    mx = __uint_as_float(__float_as_uint(top[0]) & ~16383u);
#pragma unroll
    for (int i = 0; i < 16; ++i) { wgt[i] = __expf(__uint_as_float(__float_as_uint(top[i]) & ~16383u) - mx); sum += wgt[i]; }
    const float inv = 1.f / sum;
    if (lane < 32) {
      uint4* dst = eg + ((size_t)T * 8 + h) * 8;
#pragma unroll
      for (int i = 0; i < 8; ++i) {
        dst[i] = make_uint4(__float_as_uint(top[2 * i]) & 16383u, __float_as_uint(wgt[2 * i] * inv),
                            __float_as_uint(top[2 * i + 1]) & 16383u, __float_as_uint(wgt[2 * i + 1] * inv));
      }
    }
  }
}

#define CVT8(w_, hi_) __builtin_amdgcn_cvt_pk_f32_fp8((int)(w_), hi_)
__device__ void phase_peer(const Params& p) {
  const int lane = threadIdx.x & 63;
  const int gw = blockIdx.x * 4 + (threadIdx.x >> 6), nw = gridDim.x * 4;
  const u16* h2 = (const u16*)(p.ws + OFF_RA);
  const char* ub8 = p.ws + OFF_UB + lane * 16;
  const char* vb8 = p.ws + OFF_VB + lane * 16;
  const float* su = (const float*)(p.ws + OFF_UB + (16ull << 20));
  const float* sv = (const float*)(p.ws + OFF_VB + (16ull << 20));
  const uint2* eg = (const uint2*)(p.ws + OFF_RB);
  const float* mod = (const float*)(p.ws + OFF_MOD);
  if (gw >= NT) return;
  uint2 eAn = eg[(size_t)gw * 128 + lane], eBn = eg[(size_t)gw * 128 + 64 + lane];
  u32x4 hAn = *(const u32x4*)(h2 + (size_t)gw * D + lane * 16), hBn = *(const u32x4*)(h2 + (size_t)gw * D + lane * 16 + 8);
  u32x4 ubuf[16], vbuf[16];
#pragma unroll
  for (int k = 0; k < 16; ++k) {
    const int e = __builtin_amdgcn_readlane((int)eAn.x, k);
    ubuf[k] = *(const u32x4*)(ub8 + (size_t)e * 1024);
  }
  for (int T = gw; T < NT; T += nw) {
    const int seq = T >> 14;
    const uint2 eA = eAn, eB = eBn;
    f32x2 hf[8];
    hf[0] = (f32x2){bflo(hAn[0]), bfhi(hAn[0])}; hf[1] = (f32x2){bflo(hAn[1]), bfhi(hAn[1])};
    hf[2] = (f32x2){bflo(hAn[2]), bfhi(hAn[2])}; hf[3] = (f32x2){bflo(hAn[3]), bfhi(hAn[3])};
    hf[4] = (f32x2){bflo(hBn[0]), bfhi(hBn[0])}; hf[5] = (f32x2){bflo(hBn[1]), bfhi(hBn[1])};
    hf[6] = (f32x2){bflo(hBn[2]), bfhi(hBn[2])}; hf[7] = (f32x2){bflo(hBn[3]), bfhi(hBn[3])};
    const float suA = su[eA.x], suB = su[eB.x];
    const float gsA = __uint_as_float(eA.y) * sv[eA.x], gsB = __uint_as_float(eB.y) * sv[eB.x];
    {
      const int Tn = (T + nw < NT) ? T + nw : T;
      eAn = eg[(size_t)Tn * 128 + lane]; eBn = eg[(size_t)Tn * 128 + 64 + lane];
      hAn = *(const u32x4*)(h2 + (size_t)Tn * D + lane * 16); hBn = *(const u32x4*)(h2 + (size_t)Tn * D + lane * 16 + 8);
    }
    f32x2 o[8];
#pragma unroll
    for (int i = 0; i < 8; ++i) o[i] = (f32x2){0.f, 0.f};
#pragma unroll 1
    for (int h = 0; h < 8; ++h) {
      const int ecur = (h < 4) ? (int)eA.x : (int)eB.x;
      const int base = (h & 3) * 16;
#pragma unroll
      for (int k = 0; k < 16; ++k) {
        const int e = __builtin_amdgcn_readlane(ecur, base + k);
        vbuf[k] = *(const u32x4*)(vb8 + (size_t)e * 1024);
      }
      float acc[16];
#pragma unroll
      for (int k = 0; k < 16; ++k) {
        const u32x4 a = ubuf[k];
        f32x2 s2 = hf[0] * CVT8(a[0], false);
        s2 = __builtin_elementwise_fma(hf[1], CVT8(a[0], true), s2);
        s2 = __builtin_elementwise_fma(hf[2], CVT8(a[1], false), s2);
        s2 = __builtin_elementwise_fma(hf[3], CVT8(a[1], true), s2);
        s2 = __builtin_elementwise_fma(hf[4], CVT8(a[2], false), s2);
        s2 = __builtin_elementwise_fma(hf[5], CVT8(a[2], true), s2);
        s2 = __builtin_elementwise_fma(hf[6], CVT8(a[3], false), s2);
        s2 = __builtin_elementwise_fma(hf[7], CVT8(a[3], true), s2);
        acc[k] = s2.x + s2.y;
      }
      {
        const int enx = (h < 3) ? (int)eA.x : ((h < 7) ? (int)eB.x : (int)eAn.x);
        const int base1 = ((h + 1) & 3) * 16;
#pragma unroll
        for (int k = 0; k < 16; ++k) {
          const int e = __builtin_amdgcn_readlane(enx, base1 + k);
          ubuf[k] = *(const u32x4*)(ub8 + (size_t)e * 1024);
        }
      }
      float a8[8], a4[4], a2[2], tot;
      {
        const bool up = (lane & 32) != 0;
#pragma unroll
        for (int i = 0; i < 8; ++i) { float send = up ? acc[i] : acc[i + 8]; float keep = up ? acc[i + 8] : acc[i]; a8[i] = keep + __shfl_xor(send, 32); }
      }
      {
        const bool up = (lane & 16) != 0;
#pragma unroll
        for (int i = 0; i < 4; ++i) { float send = up ? a8[i] : a8[i + 4]; float keep = up ? a8[i + 4] : a8[i]; a4[i] = keep + __shfl_xor(send, 16); }
      }
      {
        const bool up = (lane & 8) != 0;
#pragma unroll
        for (int i = 0; i < 2; ++i) { float send = up ? a4[i] : a4[i + 2]; float keep = up ? a4[i + 2] : a4[i]; a2[i] = keep + __shfl_xor(send, 8); }
      }
      {
        const bool up = (lane & 4) != 0;
        float send = up ? a2[0] : a2[1]; float keep = up ? a2[1] : a2[0]; tot = keep + __shfl_xor(send, 4);
      }
      tot += __shfl_xor(tot, 2);
      tot += __shfl_xor(tot, 1);
      const float sucur = (h < 4) ? suA : suB;
      const float gscur = (h < 4) ? gsA : gsB;
      const float suk = __shfl(sucur, base + (lane >> 2));
      const float gsk = __shfl(gscur, base + (lane >> 2));
      const float coef = gsk * gelu_tanh(suk * tot);
      const int coefb = (int)__float_as_uint(coef);
#pragma unroll
      for (int k = 0; k < 16; ++k) {
        const float ck = __uint_as_float((unsigned)__builtin_amdgcn_readlane(coefb, 4 * k));
        const f32x2 ck2 = (f32x2){ck, ck};
        const u32x4 a = vbuf[k];
        o[0] = __builtin_elementwise_fma(ck2, CVT8(a[0], false), o[0]);
        o[1] = __builtin_elementwise_fma(ck2, CVT8(a[0], true), o[1]);
        o[2] = __builtin_elementwise_fma(ck2, CVT8(a[1], false), o[2]);
        o[3] = __builtin_elementwise_fma(ck2, CVT8(a[1], true), o[3]);
        o[4] = __builtin_elementwise_fma(ck2, CVT8(a[2], false), o[4]);
        o[5] = __builtin_elementwise_fma(ck2, CVT8(a[2], true), o[5]);
        o[6] = __builtin_elementwise_fma(ck2, CVT8(a[3], false), o[6]);
        o[7] = __builtin_elementwise_fma(ck2, CVT8(a[3], true), o[7]);
      }
    }
    float* xo = p.out + (size_t)T * D + lane * 16;
    const float* g2 = mod + seq * 6144 + 5120 + lane * 16;
    const float* nf = p.norm_f_g + lane * 16;
    float4 x2[4]; float ss = 0.f;
#pragma unroll
    for (int i = 0; i < 4; ++i) {
      float4 xa = *(const float4*)(xo + 4 * i), ga = *(const float4*)(g2 + 4 * i);
      x2[i].x = xa.x + ga.x * o[2 * i].x; x2[i].y = xa.y + ga.y * o[2 * i].y;
      x2[i].z = xa.z + ga.z * o[2 * i + 1].x; x2[i].w = xa.w + ga.w * o[2 * i + 1].y;
      ss += x2[i].x * x2[i].x + x2[i].y * x2[i].y + x2[i].z * x2[i].z + x2[i].w * x2[i].w;
    }
    ss = wave_sum(ss);
    const float rstd = rsqrtf(ss * (1.f / 1024.f) + 1e-6f);
#pragma unroll
    for (int i = 0; i < 4; ++i) {
      float4 na = *(const float4*)(nf + 4 * i);
      *(float4*)(xo + 4 * i) = make_float4(x2[i].x * rstd * na.x, x2[i].y * rstd * na.y, x2[i].z * rstd * na.z, x2[i].w * rstd * na.w);
    }
  }
}

#define XB_TMO      128
#define XB_XCNT(j)  (256  + 64 * (j))
#define XB_XSUB(j)  (1280 + 64 * (j))
#define XB_XGEN(j)  (2304 + 64 * (j))
#define XB_TOP      3328
#define XB_TOPGEN   3392
#define XCD_BAR_WORDS 3456
#define XB_SPIN_CAP (1u << 18)
#define LAS __attribute__((address_space(3)))

__device__ __forceinline__ unsigned xb_ld(unsigned* p)              { return __hip_atomic_load(p, __ATOMIC_RELAXED, __HIP_MEMORY_SCOPE_AGENT); }
__device__ __forceinline__ unsigned xb_add(unsigned* p, unsigned v) { return __hip_atomic_fetch_add(p, v, __ATOMIC_RELAXED, __HIP_MEMORY_SCOPE_AGENT); }
__device__ __forceinline__ unsigned xb_xcc_id() { return (unsigned)__builtin_amdgcn_s_getreg((3 << 11) | 20) & 0xFu; }
#define XB_SPIN(cond, bar) do { unsigned _sp = 0; while (cond) { __builtin_amdgcn_s_sleep(1); \
    if ((++_sp & 255u) == 0u) { if (xb_ld(&(bar)[XB_TMO])) break; if (_sp > XB_SPIN_CAP) { atomicAdd(&(bar)[XB_TMO], 1u); break; } } } } while (0)

struct XcdBarrier {
    unsigned* bar; unsigned x;
    volatile LAS unsigned* st;
};

__device__ __forceinline__ XcdBarrier xcd_barrier_post(unsigned* bar, volatile LAS unsigned* st) {
    XcdBarrier b; b.bar = bar; b.x = xb_xcc_id(); b.st = st;
    if (threadIdx.x == 0) (void)xb_add(&bar[XB_XCNT(b.x)], 1u);
    return b;
}
__device__ __forceinline__ void xcd_barrier_complete(unsigned* bar, unsigned x, unsigned& nloc, unsigned& nx) {
    const unsigned G = gridDim.x * gridDim.y * gridDim.z;
    unsigned sum, cnt, mine, sp = 0u;
    for (;;) {
        sum = 0u; cnt = 0u; mine = 0u;
#pragma unroll
        for (unsigned j = 0; j < 16; ++j) { const unsigned c = xb_ld(&bar[XB_XCNT(j)]); sum += c; cnt += (c > 0u) ? 1u : 0u; mine = (j == x) ? c : mine; }
        if (sum == G) break;
        __builtin_amdgcn_s_sleep(1);
        if ((++sp & 255u) == 0u) { if (xb_ld(&bar[XB_TMO])) break; if (sp > XB_SPIN_CAP) { atomicAdd(&bar[XB_TMO], 1u); break; } }
    }
    nloc = mine > 0u ? mine : 1u; nx = cnt > 0u ? cnt : 1u;
}

__device__ __forceinline__ void xcd_barrier(const XcdBarrier& b) {
    asm volatile("s_waitcnt vmcnt(0)" ::: "memory");
    __syncthreads();
    if (threadIdx.x == 0) {
        unsigned* bar = b.bar;
        __builtin_amdgcn_s_waitcnt(0);
        unsigned nloc = b.st[0], nx = b.st[1];
        if (nloc == 0u) { xcd_barrier_complete(bar, b.x, nloc, nx); b.st[0] = nloc; b.st[1] = nx; }
        const unsigned old = xb_add(&bar[XB_XSUB(b.x)], 1u);
        const unsigned gen = old / nloc;
        if (old + 1u == (gen + 1u) * nloc) {
            __builtin_amdgcn_fence(__ATOMIC_RELEASE, "agent");
            asm volatile("s_waitcnt vmcnt(0)" ::: "memory");
            const unsigned og = xb_add(&bar[XB_TOP], 1u);
            const unsigned tg = og / nx;
            if (og + 1u == (tg + 1u) * nx) xb_add(&bar[XB_TOPGEN], 1u);
            else XB_SPIN(xb_ld(&bar[XB_TOPGEN]) == tg, bar);
            __builtin_amdgcn_fence(__ATOMIC_ACQUIRE, "agent");
            xb_add(&bar[XB_XGEN(b.x)], 1u);
            asm volatile("s_waitcnt vmcnt(0)" ::: "memory");
        } else {
            XB_SPIN(xb_ld(&bar[XB_XGEN(b.x)]) == gen, bar);
            __builtin_amdgcn_fence(__ATOMIC_ACQUIRE, "agent");
            asm volatile("s_waitcnt vmcnt(0)" ::: "memory");
        }
    }
    __syncthreads();
}


constexpr int SMEM_BYTES = (SMEM_LRU > SMEM_GEMM) ? SMEM_LRU : SMEM_GEMM;

__global__ void __launch_bounds__(256, 2) mega(Params p) {
  __shared__ __attribute__((aligned(16))) char smem[SMEM_BYTES];
  __shared__ uint4 xb_words;
  if (threadIdx.x == 0) xb_words = make_uint4(0u, 0u, 0u, 0u);
  __syncthreads();
  XcdBarrier xb = xcd_barrier_post((unsigned*)(p.ws + OFF_BAR), (volatile LAS unsigned*)&xb_words);
  if (p.phase_lo < 0) cg::this_grid().sync();
#define RUN_PHASE(ph_, ...)                                         \
  if (p.phase_lo <= (ph_) && (ph_) < p.phase_hi) {                  \
    __VA_ARGS__;                                                    \
    if ((ph_) + 1 < p.phase_hi) xcd_barrier(xb);                    \
  }
  RUN_PHASE(0, phase0(p, smem))
  RUN_PHASE(1, phase_norm<false>(p))
  RUN_PHASE(2, phase_gemm1(p, smem))
  RUN_PHASE(3, phase_fft1(p, smem); phase_lru_local(p, smem))
  RUN_PHASE(4, phase_carry(p); phase_fft3(p, smem))
  RUN_PHASE(5, phase_lru_fix(p))
  RUN_PHASE(6, phase_gemm2(p, smem))
  RUN_PHASE(7, phase_norm<true>(p))
  RUN_PHASE(8, phase_gemm3(p, smem))
  RUN_PHASE(9, phase_topk(p))
  RUN_PHASE(10, phase_peer(p))
}

extern "C" void kernel_launch(void* const* d_in, const int* in_sizes, int n_in, void* d_out, int out_size,
                              void* d_ws, size_t ws_size, hipStream_t stream) {
  static int grid_blocks = 0;
  if (!grid_blocks) {
    int dev = 0, cus = 0, per_cu = 0;
    hipGetDevice(&dev);
    hipDeviceGetAttribute(&cus, hipDeviceAttributeMultiprocessorCount, dev);
    hipOccupancyMaxActiveBlocksPerMultiprocessor(&per_cu, mega, 256, 0);
    if (per_cu < 1) per_cu = 1;
    if (per_cu > 2) per_cu = 2;
    grid_blocks = cus * per_cu;
  }
  if (ws_size < WS_TOTAL) { fprintf(stderr, "workspace too small: %zu < %zu\n", ws_size, (size_t)WS_TOTAL); return; }
  Params p{};
  p.x_prompt = (const float*)d_in[0]; p.x_sample = (const float*)d_in[1]; p.c_prompt = (const float*)d_in[2]; p.c_sample = (const float*)d_in[3];
  p.ada_w = (const float*)d_in[4]; p.ada_b = (const float*)d_in[5]; p.norm1_g = (const float*)d_in[6]; p.w_in = (const float*)d_in[7];
  p.fnet_w = (const float*)d_in[8]; p.conv_w = (const float*)d_in[9]; p.conv_b = (const float*)d_in[10]; p.lru_wa = (const float*)d_in[11];
  p.lru_ba = (const float*)d_in[12]; p.lru_wx = (const float*)d_in[13]; p.lru_bx = (const float*)d_in[14]; p.lru_lambda = (const float*)d_in[15];
  p.w_out = (const float*)d_in[16]; p.norm2_g = (const float*)d_in[17]; p.peer_wq = (const float*)d_in[18]; p.peer_k1 = (const float*)d_in[19];
  p.peer_k2 = (const float*)d_in[20]; p.peer_u = (const float*)d_in[21]; p.peer_v = (const float*)d_in[22]; p.norm_f_g = (const float*)d_in[23];
  p.out = (float*)d_out; p.ws = (char*)d_ws;
#if COOP
  hipMemsetAsync((char*)d_ws + OFF_BAR, 0, XCD_BAR_WORDS * sizeof(unsigned), stream);
  p.phase_lo = 0; p.phase_hi = NPHASE;
  void* args[] = {&p};
  hipError_t e = hipLaunchCooperativeKernel((void*)mega, dim3(grid_blocks), dim3(256), args, 0, stream);
  if (e != hipSuccess) fprintf(stderr, "cooperative launch failed: %s (grid %d)\n", hipGetErrorString(e), grid_blocks);
#else
  for (int ph = 0; ph < NPHASE; ++ph) {
    p.phase_lo = ph; p.phase_hi = ph + 1;
    hipLaunchKernelGGL(mega, dim3(grid_blocks), dim3(256), 0, stream, p);
  }
#endif
}
```

```cpp
#include <hip/hip_runtime.h>
#include <hip/hip_cooperative_groups.h>
#include <cstdio>
#include <cstdint>
namespace cg = cooperative_groups;

#define PROBE 0
#define U_SLICED 0
#ifndef COOP
#define COOP 1
#endif

typedef unsigned short u16;
typedef __attribute__((ext_vector_type(8))) short bf16x8;
typedef __attribute__((ext_vector_type(4))) short s16x4;
typedef __attribute__((ext_vector_type(4))) float f32x4;
typedef __attribute__((ext_vector_type(16))) float f32x16;
typedef short v4i16_t __attribute__((ext_vector_type(4)));
typedef unsigned int u32x4 __attribute__((ext_vector_type(4)));
typedef float f32x2 __attribute__((ext_vector_type(2)));

constexpr int D = 1024;
constexpr int SEQ = 16384;
constexpr int NSEQ = 3;
constexpr int NT = NSEQ * SEQ;
constexpr int NCH = 256;
constexpr int NPHASE = 13;

constexpr size_t OFF_MOD   = 0;
constexpr size_t OFF_BAR   = 512ull << 10;
constexpr size_t OFF_W1T   = 1ull << 20;
constexpr size_t OFF_W2T   = OFF_W1T + (4ull << 20);
constexpr size_t OFF_WQT   = OFF_W2T + (2ull << 20);
constexpr size_t OFF_K1B   = OFF_WQT + (4ull << 20);
constexpr size_t OFF_K2B   = OFF_K1B + (256ull << 10);
constexpr size_t OFF_WAT   = OFF_K2B + (256ull << 10);
constexpr size_t OFF_A1    = OFF_WAT + (256ull << 10);
constexpr size_t OFF_SUMP  = OFF_A1 + (256ull << 10);
constexpr size_t OFF_SUMH  = OFF_SUMP + (3ull << 20);
constexpr size_t OFF_CARRY = OFF_SUMH + (3ull << 20);
constexpr size_t OFF_MTAB  = OFF_CARRY + (3ull << 20);
constexpr size_t OFF_UB    = OFF_MTAB + (8ull << 20);
constexpr size_t OFF_VB    = OFF_UB + (32ull << 20);
constexpr size_t OFF_RA    = OFF_VB + (32ull << 20);
constexpr size_t OFF_RB    = OFF_RA + (96ull << 20);
constexpr size_t OFF_RC    = OFF_RB + (96ull << 20);
constexpr size_t WS_TOTAL  = OFF_RC + (192ull << 20);

struct Params {
  const float* x_prompt; const float* x_sample; const float* c_prompt; const float* c_sample;
  const float* ada_w; const float* ada_b; const float* norm1_g; const float* w_in; const float* fnet_w;
  const float* conv_w; const float* conv_b; const float* lru_wa; const float* lru_ba; const float* lru_wx;
  const float* lru_bx; const float* lru_lambda; const float* w_out; const float* norm2_g; const float* peer_wq;
  const float* peer_k1; const float* peer_k2; const float* peer_u; const float* peer_v; const float* norm_f_g;
  float* out; char* ws;
  int phase_lo; int phase_hi;
};

__device__ __forceinline__ unsigned pack2(float a, float b) { unsigned r; asm volatile("v_cvt_pk_bf16_f32 %0, %1, %2" : "=v"(r) : "v"(a), "v"(b)); return r; }
__device__ __forceinline__ unsigned f2bf(float f) { return pack2(f, 0.f) & 0xFFFFu; }
__device__ __forceinline__ float bflo(unsigned u) { return __uint_as_float(u << 16); }
__device__ __forceinline__ float bfhi(unsigned u) { return __uint_as_float(u & 0xFFFF0000u); }
__device__ __forceinline__ float sigmoidf_(float x) { return __builtin_amdgcn_rcpf(1.f + __expf(-x)); }
__device__ __forceinline__ float gelu_tanh(float x) {
  float y = 0.7978845608028654f * (x + 0.044715f * x * x * x);
  return x * __builtin_amdgcn_rcpf(1.f + __expf(-2.f * y));
}
__device__ __forceinline__ float wave_sum(float v) {
#pragma unroll
  for (int o = 32; o > 0; o >>= 1) v += __shfl_xor(v, o);
  return v;
}
__device__ __forceinline__ const float* xrow(const Params& p, int T) {
  return (T < 2 * SEQ) ? p.x_prompt + (size_t)T * D : p.x_sample + (size_t)(T - 2 * SEQ) * D;
}

constexpr int BK = 64;
constexpr int LDSA = BK + 8;
constexpr int LDSB_NN = 128 + 8;
constexpr int SMEM_GEMM = 2 * 128 * LDSA * 2;

template <int BMODE, class ARow, class BRow, class Epi>
__device__ __forceinline__ void gemm_tile(ARow arow, BRow brow, int K, Epi epi, char* smem, const int tid) {
  u16* sA = (u16*)smem;
  u16* sB = sA + 128 * LDSA;
  const int lane = tid & 63, w = tid >> 6;
  const int wm = w >> 1, wn = w & 1;
  f32x4 acc[4][4];
#pragma unroll
  for (int i = 0; i < 4; ++i)
#pragma unroll
    for (int j = 0; j < 4; ++j) acc[i][j] = (f32x4){0.f, 0.f, 0.f, 0.f};

  const u16* pa[4];
  const u16* pb[4];
#pragma unroll
  for (int i = 0; i < 4; ++i) {
    int c = tid + 256 * i;
    pa[i] = arow(c >> 3) + (c & 7) * 8;
    if (BMODE == 0) pb[i] = brow(c >> 3) + (c & 7) * 8;
  }
  u32x4 ra[4], rb[4];
#define GLOAD(k0_)                                                                                       \
  _Pragma("unroll") for (int i = 0; i < 4; ++i) {                                                        \
    ra[i] = *(const u32x4*)(pa[i] + (k0_));                                                              \
    if (BMODE == 0) rb[i] = *(const u32x4*)(pb[i] + (k0_));                                              \
    else { int c = tid + 256 * i; rb[i] = *(const u32x4*)(brow((k0_) + (c >> 4)) + (c & 15) * 8); }      \
  }
  GLOAD(0)
  for (int k0 = 0; k0 < K; k0 += BK) {
    __syncthreads();
#pragma unroll
    for (int i = 0; i < 4; ++i) {
      int c = tid + 256 * i;
      *(u32x4*)(sA + (c >> 3) * LDSA + (c & 7) * 8) = ra[i];
      if (BMODE == 0) *(u32x4*)(sB + (c >> 3) * LDSA + (c & 7) * 8) = rb[i];
      else *(u32x4*)(sB + (c >> 4) * LDSB_NN + (c & 15) * 8) = rb[i];
    }
    __syncthreads();
    if (k0 + BK < K) { GLOAD(k0 + BK) }
#pragma unroll 1
    for (int kk = 0; kk < 2; ++kk) {
      bf16x8 af[4], bfr[4];
#pragma unroll
      for (int mt = 0; mt < 4; ++mt)
        af[mt] = *(const bf16x8*)(sA + (wm * 64 + mt * 16 + (lane & 15)) * LDSA + kk * 32 + (lane >> 4) * 8);
#pragma unroll
      for (int nt = 0; nt < 4; ++nt) {
        if (BMODE == 0) {
          bfr[nt] = *(const bf16x8*)(sB + (wn * 64 + nt * 16 + (lane & 15)) * LDSA + kk * 32 + (lane >> 4) * 8);
        } else {
          int g = lane >> 4, i16 = lane & 15, q = i16 >> 2, pq = i16 & 3;
          const u16* ad = sB + (kk * 32 + 8 * g + q) * LDSB_NN + wn * 64 + nt * 16 + 4 * pq;
          v4i16_t lo = __builtin_amdgcn_ds_read_tr16_b64_v4i16((__attribute__((address_space(3))) v4i16_t*)(ad));
          v4i16_t hi = __builtin_amdgcn_ds_read_tr16_b64_v4i16((__attribute__((address_space(3))) v4i16_t*)(ad + 4 * LDSB_NN));
          bfr[nt] = (bf16x8){lo[0], lo[1], lo[2], lo[3], hi[0], hi[1], hi[2], hi[3]};
        }
      }
#pragma unroll
      for (int mt = 0; mt < 4; ++mt)
#pragma unroll
        for (int nt = 0; nt < 4; ++nt)
          acc[mt][nt] = __builtin_amdgcn_mfma_f32_16x16x32_bf16(af[mt], bfr[nt], acc[mt][nt], 0, 0, 0);
    }
  }
#pragma unroll
  for (int mt = 0; mt < 4; ++mt)
#pragma unroll
    for (int nt = 0; nt < 4; ++nt)
#pragma unroll
      for (int j = 0; j < 4; ++j)
        epi(wm * 64 + mt * 16 + (lane >> 4) * 4 + j, wn * 64 + nt * 16 + (lane & 15), acc[mt][nt][j]);
}

__device__ void phase0(const Params& p, char* smem) {
  const int tid = threadIdx.x, nb = gridDim.x, bid = blockIdx.x;
  float* sf = (float*)smem;
  float* mod = (float*)(p.ws + OFF_MOD);
  float* scs = sf + 2048;
  for (int i = tid; i < 3072; i += 512) {
    float c = (i < 2048) ? p.c_prompt[i] : p.c_sample[i - 2048];
    scs[i] = c * sigmoidf_(c);
  }
  __syncthreads();
  for (int item = bid; item < 96; item += nb) {
    int col = item * 64 + (tid & 63), ks = tid >> 6;
    float a0 = 0.f, a1 = 0.f, a2 = 0.f;
#pragma unroll 32
    for (int k = ks * 128; k < ks * 128 + 128; ++k) {
      float wv = p.ada_w[(size_t)k * 6144 + col];
      a0 += scs[k] * wv; a1 += scs[1024 + k] * wv; a2 += scs[2048 + k] * wv;
    }
    __syncthreads();
    sf[tid * 3 + 0] = a0; sf[tid * 3 + 1] = a1; sf[tid * 3 + 2] = a2;
    __syncthreads();
    if (tid < 64) {
      float bsum = p.ada_b[col];
#pragma unroll
      for (int s = 0; s < 3; ++s) {
        float v = 0.f;
#pragma unroll
        for (int q = 0; q < 8; ++q) v += sf[(tid + 64 * q) * 3 + s];
        mod[s * 6144 + col] = v + bsum;
      }
    }
  }
  __syncthreads();
  float* ct = sf + 1600; float* st = sf + 1600 + 64;
  if (tid < 64) { ct[tid] = cospif(tid / 32.f); st[tid] = sinpif(tid / 32.f); }
  __syncthreads();
  const size_t gtid = (size_t)bid * 512 + tid, gstride = (size_t)nb * 512;
  {
    u16* w1T = (u16*)(p.ws + OFF_W1T);
    for (size_t idx = gtid; idx < 2048ull * 1024; idx += gstride) {
      const int nl = (int)(idx & 63), k = (int)((idx >> 6) & 1023), nh = (int)(idx >> 16);
      const int n = nh * 64 + nl;
      float v;
      if (n < 1024) {
        int comp = n >> 9, g = (n >> 6) & 7, kk = n & 63;
        const float* src = p.w_in + (size_t)k * 1536 + g * 64;
        float s = 0.f;
#pragma unroll 8
        for (int c = 0; c < 64; ++c) {
          int j = (c * kk) & 63;
          float tw = comp ? -st[j] : ct[j];
          s += src[c] * tw;
        }
        v = s;
      } else {
        v = p.w_in[(size_t)k * 1536 + (n - 512)];
      }
      w1T[(size_t)n * 1024 + k] = (u16)f2bf(v);
    }
  }
  {
    u16* w2T = (u16*)(p.ws + OFF_W2T);
    for (size_t idx = gtid; idx < 1024ull * 1024; idx += gstride) {
      const int n = (int)(idx & 1023), k = (int)(idx >> 10);
      float v;
      if (k < 512) {
        int g = k >> 6;
        const float* fw = p.fnet_w + (size_t)k * 64;
        const float* wo = p.w_out + (size_t)(g * 64) * 1024 + n;
        float s = 0.f;
#pragma unroll
        for (int d = 0; d < 64; ++d) s += fw[d] * wo[(size_t)d * 1024];
        v = s * (1.f / 1024.f);
      } else {
        v = p.w_out[(size_t)k * 1024 + n];
      }
      w2T[(size_t)n * 1024 + k] = (u16)f2bf(v);
    }
  }
  {
    uint2* wqb = (uint2*)(p.ws + OFF_UB + (20ull << 20));
    const float4* src = (const float4*)p.peer_wq;
    for (size_t idx = gtid; idx < 2048ull * 1024 / 4; idx += gstride) { const float4 a = src[idx]; wqb[idx] = make_uint2(pack2(a.x, a.y), pack2(a.z, a.w)); }
  }
  {
    float* clt = (float*)(p.ws + OFF_MOD + (128ull << 10));
    for (size_t idx = gtid; idx < 1024; idx += gstride) clt[idx] = -8.f * log1pf(expf(-p.lru_lambda[idx]));
  }
  {
    u16* k1b = (u16*)(p.ws + OFF_K1B); u16* k2b = (u16*)(p.ws + OFF_K2B);
    for (size_t idx = gtid; idx < 131072; idx += gstride) { k1b[idx] = (u16)f2bf(p.peer_k1[idx]); k2b[idx] = (u16)f2bf(p.peer_k2[idx]); }
  }
  {
    u16* waT = (u16*)(p.ws + OFF_WAT);
    for (size_t idx = gtid; idx < 131072; idx += gstride) {
      int i = idx & 63, j = (idx >> 6) & 63, h = (idx >> 12) & 7, gate = (idx >> 15) & 1, d = (int)(idx >> 16);
      const float* src = gate ? p.lru_wx : p.lru_wa;
      waT[idx] = (u16)f2bf(src[((size_t)(d * 8 + h) * 64 + i) * 64 + j]);
    }
  }
  {
    u16* A1 = (u16*)(p.ws + OFF_A1);
    for (size_t idx = gtid; idx < 65536; idx += gstride) {
      int m = (int)(idx >> 8), k = (int)(idx & 255);
      int cp = m >> 7, k1 = m & 127, comp = k >> 7, s1 = k & 127;
      int j = (k1 * s1) & 127;
      float C = cospif(j / 64.f), S = sinpif(j / 64.f);
      float v = (cp == comp) ? C : (cp == 0 ? S : -S);
      A1[idx] = (u16)f2bf(v);
    }
    u16* Mt = (u16*)(p.ws + OFF_MTAB);
    for (size_t idx = gtid; idx < 128ull * 128 * 256; idx += gstride) {
      int k = (int)(idx & 255), k2 = (int)((idx >> 8) & 127), k1 = (int)(idx >> 15);
      int comp = k >> 7, s2 = k & 127;
      int j = (s2 * (k1 + 128 * k2)) & 16383;
      float v = comp ? sinpif(j / 8192.f) : cospif(j / 8192.f);
      Mt[idx] = (u16)f2bf(v);
    }
  }
  {
    const int lane = tid & 63;
    const int gwv = bid * 8 + (tid >> 6), nwv = nb * 8;
    for (int row0 = gwv; row0 < 32768; row0 += 4 * nwv) {
      float4 f[4][4];
#pragma unroll
      for (int r = 0; r < 4; ++r) {
        const int row = (row0 + r * nwv < 32768) ? row0 + r * nwv : row0;
        const float* src = ((row >> 14) ? p.peer_v : p.peer_u) + (size_t)(row & 16383) * D + lane * 16;
#pragma unroll
        for (int i = 0; i < 4; ++i) f[r][i] = *(const float4*)(src + 4 * i);
      }
#pragma unroll
      for (int r = 0; r < 4; ++r) {
        const int row = row0 + r * nwv;
        if (row < 32768) {
          const int tbl = row >> 14, e = row & 16383;
          float m = 0.f;
#pragma unroll
          for (int i = 0; i < 4; ++i) m = fmaxf(m, fmaxf(fmaxf(fabsf(f[r][i].x), fabsf(f[r][i].y)), fmaxf(fabsf(f[r][i].z), fabsf(f[r][i].w))));
#pragma unroll
          for (int o = 32; o > 0; o >>= 1) m = fmaxf(m, __shfl_xor(m, o));
          const float inv = (m > 0.f) ? 224.f / m : 0.f;
          const float scl = (m > 0.f) ? m * (1.f / 224.f) : 0.f;
          int dd[4];
#pragma unroll
          for (int i = 0; i < 4; ++i) {
            dd[i] = __builtin_amdgcn_cvt_pk_fp8_f32(f[r][i].x * inv, f[r][i].y * inv, 0, false);
            dd[i] = __builtin_amdgcn_cvt_pk_fp8_f32(f[r][i].z * inv, f[r][i].w * inv, dd[i], true);
          }
          char* dst = p.ws + (tbl ? OFF_VB : OFF_UB);
          const size_t doff = tbl ? ((size_t)(lane >> 3) * (16384ull * 128) + (size_t)e * 128 + (lane & 7) * 16) : ((size_t)e * 1024 + lane * 16);
          *(uint4*)(dst + doff) = make_uint4((unsigned)dd[0], (unsigned)dd[1], (unsigned)dd[2], (unsigned)dd[3]);
          if (lane == 0) ((float*)(dst + (16ull << 20)))[e] = scl;
        }
      }
    }
  }
}

template <bool SECOND>
__device__ void phase_norm(const Params& p) {
  const int lane = threadIdx.x & 63;
  const int gw = blockIdx.x * 8 + (threadIdx.x >> 6), nw = gridDim.x * 8;
  const float* mod = (const float*)(p.ws + OFF_MOD);
  const float* gain = SECOND ? p.norm2_g : p.norm1_g;
  u16* dst = (u16*)(p.ws + OFF_RA);
  constexpr int R = 3;
  int cseq = -1;
  float4 gs[4], sh4[4];
  for (int T0 = gw; T0 < NT; T0 += nw * R) {
    float4 v[R][4];
#pragma unroll
    for (int r = 0; r < R; ++r) {
      const int T = (T0 + r * nw < NT) ? T0 + r * nw : T0;
      const float* xr = SECOND ? (p.out + (size_t)T * D) : xrow(p, T);
#pragma unroll
      for (int i = 0; i < 4; ++i) v[r][i] = ((const float4*)xr)[lane + 64 * i];
    }
#pragma unroll
    for (int r = 0; r < R; ++r) {
      const int T = T0 + r * nw;
      if (T < NT) {
        const int seq = T >> 14;
        if (seq != cseq) {
          cseq = seq;
          const float* sh = mod + seq * 6144 + (SECOND ? 3072 : 0);
          const float* sc = mod + seq * 6144 + (SECOND ? 4096 : 1024);
#pragma unroll
          for (int i = 0; i < 4; ++i) {
            const int col = 4 * (lane + 64 * i);
            const float4 g = *(const float4*)(gain + col), s1 = *(const float4*)(sc + col);
            gs[i] = make_float4(g.x * (1.f + s1.x), g.y * (1.f + s1.y), g.z * (1.f + s1.z), g.w * (1.f + s1.w));
            sh4[i] = *(const float4*)(sh + col);
          }
        }
        float ss = 0.f;
#pragma unroll
        for (int i = 0; i < 4; ++i) ss += v[r][i].x * v[r][i].x + v[r][i].y * v[r][i].y + v[r][i].z * v[r][i].z + v[r][i].w * v[r][i].w;
        ss = wave_sum(ss);
        const float rstd = rsqrtf(ss * (1.f / 1024.f) + 1e-6f);
#pragma unroll
        for (int i = 0; i < 4; ++i) {
          const int col = 4 * (lane + 64 * i);
          const float y0 = v[r][i].x * rstd * gs[i].x + sh4[i].x;
          const float y1 = v[r][i].y * rstd * gs[i].y + sh4[i].y;
          const float y2 = v[r][i].z * rstd * gs[i].z + sh4[i].z;
          const float y3 = v[r][i].w * rstd * gs[i].w + sh4[i].w;
          *(uint2*)(dst + (size_t)T * D + col) = make_uint2(pack2(y0, y1), pack2(y2, y3));
        }
      }
    }
  }
}


namespace pg8 {
#define PG8_LAS __attribute__((address_space(3)))
typedef unsigned short bf16_t;
typedef short bf16x8 __attribute__((ext_vector_type(8)));
typedef float f32x4 __attribute__((ext_vector_type(4)));
typedef unsigned u32x4 __attribute__((ext_vector_type(4)));
constexpr int BM = 256, BK = 64, HALF = 128, HTB = HALF * BK * 2  , STAGE_BYTES = 8 * HTB, NXCD = 8, WGM = 8;

__host__ __device__ __forceinline__ int lds_byte(int r, int c) { const int st = (r >> 4) * 2 + (c >> 5), rr = r & 15, cc = c & 31, ob = rr * 64 + cc * 2; return st * 1024 + (ob ^ (((ob >> 9) & 1) << 5)); }
__host__ __device__ __forceinline__ void stage_rc(int b, int& R, int& C) { const int st = b / 1024, sb = b % 1024, swz = sb ^ (((sb >> 9) & 1) << 5); R = (st >> 1) * 16 + swz / 64; C = (st & 1) * 32 + (swz % 64) / 2; }
__host__ __device__ __forceinline__ int perm32(int rho) { const int n = rho >> 4, i = rho & 15; return 8 * (i >> 2) + 4 * n + (i & 3); }

struct Unit { int pm, pn; };
struct Gemm { const bf16_t* A; const bf16_t* Bt; int M, N, K; };

struct StaticOrder {
    int nM, nN, nwg, G, c;
    __host__ __device__ void init(int M, int N, int G_, int c_) { nM = M / BM; nN = N / BM; nwg = nM * nN; G = G_; c = c_; }
    __host__ __device__ bool next(int i, Unit& u) const {
        const long L = (long)i * G + c; if (L >= nwg) return false;
        int wgid = (int)L; { const int q = nwg / NXCD, r = nwg % NXCD, xcd = wgid % NXCD, off = wgid / NXCD; wgid = (xcd < r ? xcd * (q + 1) : r * (q + 1) + (xcd - r) * q) + off; }
        const int nig = WGM * nN, gid = wgid / nig, fm = gid * WGM, gsz = (nM - fm) < WGM ? (nM - fm) : WGM;
        u.pm = fm + ((wgid % nig) % gsz); u.pn = (wgid % nig) / gsz; return true;
    }
    __device__ __forceinline__ void a_ready(const Unit&) const {}
    __device__ __forceinline__ void done(const Unit&) const {}
};
__device__ __forceinline__ unsigned cvt_pk_bf16(float lo, float hi) { unsigned r; asm volatile("v_cvt_pk_bf16_f32 %0, %1, %2" : "=v"(r) : "v"(lo), "v"(hi)); return r; }
template <class Epi, class Sched, bool STAMP = false>
__device__ __forceinline__ void gemm_phase(PG8_LAS unsigned char* lds, const Gemm g, const Sched& S, const Epi& E, unsigned long long* stamps) {
    const int tid = threadIdx.x, wid = __builtin_amdgcn_readfirstlane(tid >> 6), lane = tid & 63, wr = wid >> 2, wc = wid & 3, fr = lane & 15, fq = lane >> 4;
    const int K = g.K, nt = K / BK;
    int ts_lo = 0, ts_hi = 0, nts = 0; const unsigned long long rt_entry = 0ull;
#define PG8_STAMP() do { if (STAMP && wid == 0 && nts < 64) { const unsigned long long _c = (unsigned long long)clock64(); \
        ts_lo = (lane == nts) ? (int)(unsigned)_c : ts_lo; ts_hi = (lane == nts) ? (int)(unsigned)(_c >> 32) : ts_hi; ++nts; } } while (0)
    PG8_STAMP();
    unsigned voffA[2], voffB[2];
#pragma unroll
    for (int i = 0; i < 2; ++i) { int R, C; stage_rc(tid * 16 + i * 8192, R, C); const int Rb = Epi::PERM ? ((R & ~31) + perm32(R & 31)) : R;
        voffA[i] = (unsigned)(R * K + C) * 2u; voffB[i] = (unsigned)(Rb * K + C) * 2u; }
    const size_t kstep = (size_t)(BK * 2);
    const size_t hstep = (size_t)HALF * K * 2;
    const size_t tstep = 2 * hstep;
    const unsigned ldsw = (unsigned)wid * 1024u;
    const int aoff = lds_byte(wr * 64 + fr, fq * 8), boff = lds_byte(wc * 32 + fr, fq * 8);
#define PG8_SA(b, h) (((b) * 2 + (h)) * HTB)
#define PG8_SB(b, h) ((4 + (b) * 2 + (h)) * HTB)
#define PG8_STAGE(bufoff, gbase, voff) do { _Pragma("unroll") for (int _i = 0; _i < 2; ++_i) \
        __builtin_amdgcn_global_load_lds((const unsigned*)((const char*)(gbase) + (voff)[_i]), (PG8_LAS unsigned*)(lds + (bufoff) + ldsw + _i * 8192), 16, 0, 0); } while (0)
#define PG8_LDA(dst, b, h) do { _Pragma("unroll") for (int m = 0; m < 4; ++m) _Pragma("unroll") for (int k = 0; k < 2; ++k) dst[m][k] = *(const PG8_LAS bf16x8*)(lds + PG8_SA(b, h) + aoff + m * 2048 + k * 1024); } while (0)
#define PG8_LDB(dst, b, h) do { _Pragma("unroll") for (int n = 0; n < 2; ++n) _Pragma("unroll") for (int k = 0; k < 2; ++k) dst[n][k] = *(const PG8_LAS bf16x8*)(lds + PG8_SB(b, h) + boff + n * 2048 + k * 1024); } while (0)
#define PG8_MMA(ai, bj, At, Bt) do { __builtin_amdgcn_s_setprio(1); _Pragma("unroll") for (int m = 0; m < 4; ++m) _Pragma("unroll") for (int n = 0; n < 2; ++n) _Pragma("unroll") for (int k = 0; k < 2; ++k) \
        acc[ai][bj][m][n] = __builtin_amdgcn_mfma_f32_16x16x32_bf16(Bt[n][k], At[m][k], acc[ai][bj][m][n], 0, 0, 0); __builtin_amdgcn_s_setprio(0); } while (0)
#define PG8_WAIT_V(n) asm volatile("s_waitcnt vmcnt(" #n ")" ::: "memory")
#define PG8_WAIT_L(n) asm volatile("s_waitcnt lgkmcnt(" #n ")" ::: "memory")
#define PG8_BAR __builtin_amdgcn_s_barrier()
#define PG8_SCHED __builtin_amdgcn_sched_barrier(0)
    Unit cur, nxt; int ui = 0;
    if (!S.next(0, cur)) return;
    f32x4 acc[2][2][4][2];
#pragma unroll
    for (int a = 0; a < 2; ++a)
#pragma unroll
        for (int b = 0; b < 2; ++b)
#pragma unroll
            for (int m = 0; m < 4; ++m)
#pragma unroll
                for (int n = 0; n < 2; ++n) acc[a][b][m][n] = (f32x4){0.f, 0.f, 0.f, 0.f};
    bf16x8 At[4][2], B0[2][2], B1[2][2];
    const char* cA = (const char*)g.A + (size_t)cur.pm * tstep; const char* cB = (const char*)g.Bt + (size_t)cur.pn * tstep;
    S.a_ready(cur);
    PG8_STAGE(PG8_SB(0, 0), cB, voffB); PG8_STAGE(PG8_SA(0, 0), cA, voffA); PG8_STAGE(PG8_SB(0, 1), cB + hstep, voffB); PG8_STAGE(PG8_SA(0, 1), cA + hstep, voffA);
    if (wr == 1) PG8_BAR;
    PG8_WAIT_V(4); PG8_BAR;
    PG8_STAGE(PG8_SB(1, 0), cB + kstep, voffB); PG8_STAGE(PG8_SA(1, 0), cA + kstep, voffA); PG8_STAGE(PG8_SB(1, 1), cB + hstep + kstep, voffB);
    PG8_WAIT_V(6); PG8_BAR;
    PG8_STAMP();
    for (;;) {
        const bool has_next = S.next(ui + 1, nxt);
        const char* nA = has_next ? (const char*)g.A + (size_t)nxt.pm * tstep : cA; const char* nB = has_next ? (const char*)g.Bt + (size_t)nxt.pn * tstep : cB;
        for (int t = 0; t < nt; t += 2) {
            const bool last = (t == nt - 2);
            const char* a1 = cA + (size_t)(t + 1) * kstep;
            const char* a2 = last ? nA : cA + (size_t)(t + 2) * kstep; const char* b2 = last ? nB : cB + (size_t)(t + 2) * kstep;
            const char* a3 = a2 + kstep; const char* b3 = b2 + kstep;
            if (last && has_next) S.a_ready(nxt);
            PG8_LDB(B0, 0, 0); PG8_SCHED; PG8_LDA(At, 0, 0); PG8_STAGE(PG8_SA(1, 1), a1 + hstep, voffA);
            PG8_WAIT_L(8); PG8_BAR; PG8_WAIT_L(0); PG8_MMA(0, 0, At, B0); PG8_BAR; PG8_SCHED;
            PG8_LDB(B1, 0, 1); PG8_STAGE(PG8_SB(0, 0), b2, voffB);
            PG8_BAR; PG8_WAIT_L(0); PG8_MMA(0, 1, At, B1); PG8_BAR;
            PG8_LDA(At, 0, 1); PG8_STAGE(PG8_SA(0, 0), a2, voffA);
            PG8_BAR; PG8_WAIT_L(0); PG8_MMA(1, 0, At, B0); PG8_BAR; PG8_SCHED;
            PG8_STAGE(PG8_SB(0, 1), b2 + hstep, voffB);
            PG8_WAIT_V(6); PG8_BAR; PG8_MMA(1, 1, At, B1); PG8_BAR;
            PG8_LDB(B0, 1, 0); PG8_SCHED; PG8_LDA(At, 1, 0); PG8_STAGE(PG8_SA(0, 1), a2 + hstep, voffA);
            PG8_WAIT_L(8); PG8_BAR; PG8_WAIT_L(0); PG8_MMA(0, 0, At, B0); PG8_BAR; PG8_SCHED;
            PG8_LDB(B1, 1, 1); PG8_STAGE(PG8_SB(1, 0), b3, voffB);
            PG8_BAR; PG8_WAIT_L(0); PG8_MMA(0, 1, At, B1); PG8_BAR;
            PG8_LDA(At, 1, 1); PG8_STAGE(PG8_SA(1, 0), a3, voffA);
            PG8_BAR; PG8_WAIT_L(0); PG8_MMA(1, 0, At, B0); PG8_BAR; PG8_SCHED;
            PG8_STAGE(PG8_SB(1, 1), b3 + hstep, voffB);
            PG8_WAIT_V(6); PG8_BAR; PG8_MMA(1, 1, At, B1); PG8_BAR;
        }
        PG8_STAMP();
        if constexpr (!Epi::AFTER_DRAIN) { E(acc, cur, wr, wc, fr, fq); S.done(cur); }
        PG8_STAMP();
        if (!has_next) break;
#pragma unroll
        for (int a = 0; a < 2; ++a)
#pragma unroll
            for (int b = 0; b < 2; ++b)
#pragma unroll
                for (int m = 0; m < 4; ++m)
#pragma unroll
                    for (int n = 0; n < 2; ++n) acc[a][b][m][n] = (f32x4){0.f, 0.f, 0.f, 0.f};
        cur = nxt; cA = nA; cB = nB; ++ui;
    }
    PG8_WAIT_V(0);
    if (wr == 0) PG8_BAR;
    PG8_BAR;
    if constexpr (Epi::AFTER_DRAIN) { E.fused(acc, cur, wr, wc, fr, fq, lds, wid, lane); S.done(cur); }
    PG8_STAMP();
    if (STAMP && wid == 0) { stamps[lane] = lane < nts ? (((unsigned long long)(unsigned)ts_hi << 32) | (unsigned)ts_lo) : 0ull;
        if (lane == 62) stamps[62] = rt_entry; }
#undef PG8_STAMP
#undef PG8_SA
#undef PG8_SB
#undef PG8_STAGE
#undef PG8_LDA
#undef PG8_LDB
#undef PG8_MMA
#undef PG8_WAIT_V
#undef PG8_WAIT_L
#undef PG8_BAR
#undef PG8_SCHED
}
}

struct EpiG1 {
  static constexpr bool PERM = true, AFTER_DRAIN = false;
  u16* Z; u16* ux; u16* gg;
  __device__ __forceinline__ void operator()(const pg8::f32x4 (&acc)[2][2][4][2], const pg8::Unit& u, int wr, int wc, int fr, int fq) const {
    const int row0 = u.pm * 256 + wr * 64 + fr;
    u16* base; int ld, colt; bool act = false;
    if (u.pn < 4) { base = Z; ld = 1024; colt = u.pn * 256; }
    else if (u.pn < 6) { base = ux; ld = 512; colt = (u.pn - 4) * 256; }
    else { base = gg; ld = 512; colt = (u.pn - 6) * 256; act = true; }
    const int col0 = colt + wc * 32 + 8 * fq;
#pragma unroll
    for (int ai = 0; ai < 2; ++ai)
#pragma unroll
      for (int m = 0; m < 4; ++m) {
        u16* rowp = base + (size_t)(row0 + ai * 128 + m * 16) * ld + col0;
#pragma unroll
        for (int bj = 0; bj < 2; ++bj) {
          pg8::f32x4 v0 = acc[ai][bj][m][0], v1 = acc[ai][bj][m][1];
          if (act) {
#pragma unroll
            for (int j = 0; j < 4; ++j) { v0[j] = gelu_tanh(v0[j]); v1[j] = gelu_tanh(v1[j]); }
          }
          u32x4 wv; wv.x = pg8::cvt_pk_bf16(v0[0], v0[1]); wv.y = pg8::cvt_pk_bf16(v0[2], v0[3]); wv.z = pg8::cvt_pk_bf16(v1[0], v1[1]); wv.w = pg8::cvt_pk_bf16(v1[2], v1[3]);
          *(u32x4*)(rowp + bj * 128) = wv;
        }
      }
  }
};
struct EpiG2 {
  static constexpr bool PERM = false, AFTER_DRAIN = false;
  const float* xp; const float* xs; const float* mod; float* out;
  __device__ __forceinline__ void operator()(const pg8::f32x4 (&acc)[2][2][4][2], const pg8::Unit& u, int wr, int wc, int fr, int fq) const {
    const int row0 = u.pm * 256 + wr * 64 + fr, col0 = u.pn * 256 + wc * 32 + 4 * fq;
    const int seq = (u.pm * 256) >> 14;
    const float* g1 = mod + seq * 6144 + 2048 + col0;
    pg8::f32x4 gv[2][2];
#pragma unroll
    for (int bj = 0; bj < 2; ++bj)
#pragma unroll
      for (int n = 0; n < 2; ++n) gv[bj][n] = *(const pg8::f32x4*)(g1 + bj * 128 + n * 16);
#pragma unroll
    for (int ai = 0; ai < 2; ++ai) {
      pg8::f32x4 xv[4][2][2];
#pragma unroll
      for (int m = 0; m < 4; ++m) {
        const int T = row0 + ai * 128 + m * 16;
        const float* xr = ((T < 2 * SEQ) ? xp + (size_t)T * D : xs + (size_t)(T - 2 * SEQ) * D) + col0;
#pragma unroll
        for (int bj = 0; bj < 2; ++bj)
#pragma unroll
          for (int n = 0; n < 2; ++n) xv[m][bj][n] = *(const pg8::f32x4*)(xr + bj * 128 + n * 16);
      }
#pragma unroll
      for (int m = 0; m < 4; ++m) {
        const int T = row0 + ai * 128 + m * 16;
        float* orow = out + (size_t)T * D + col0;
#pragma unroll
        for (int bj = 0; bj < 2; ++bj)
#pragma unroll
          for (int n = 0; n < 2; ++n) *(pg8::f32x4*)(orow + bj * 128 + n * 16) = xv[m][bj][n] + gv[bj][n] * acc[ai][bj][m][n];
      }
    }
  }
};
struct EpiG3 {
  static constexpr bool PERM = true, AFTER_DRAIN = false;
  u16* q;
  __device__ __forceinline__ void operator()(const pg8::f32x4 (&acc)[2][2][4][2], const pg8::Unit& u, int wr, int wc, int fr, int fq) const {
    const int row0 = u.pm * 256 + wr * 64 + fr, col0 = u.pn * 256 + wc * 32 + 8 * fq;
#pragma unroll
    for (int ai = 0; ai < 2; ++ai)
#pragma unroll
      for (int m = 0; m < 4; ++m) {
        u16* rowp = q + (size_t)(row0 + ai * 128 + m * 16) * 2048 + col0;
#pragma unroll
        for (int bj = 0; bj < 2; ++bj) {
          const pg8::f32x4 v0 = acc[ai][bj][m][0], v1 = acc[ai][bj][m][1];
          u32x4 wv; wv.x = pg8::cvt_pk_bf16(v0[0], v0[1]); wv.y = pg8::cvt_pk_bf16(v0[2], v0[3]); wv.z = pg8::cvt_pk_bf16(v1[0], v1[1]); wv.w = pg8::cvt_pk_bf16(v1[2], v1[3]);
          *(u32x4*)(rowp + bj * 128) = wv;
        }
      }
  }
};
__device__ void phase_gemm1(const Params& p, char* smem) {
  pg8::Gemm g; g.A = (const u16*)(p.ws + OFF_RA); g.Bt = (const u16*)(p.ws + OFF_W1T); g.M = NT; g.N = 2048; g.K = D;
  pg8::StaticOrder S; S.init(NT, 2048, gridDim.x, blockIdx.x);
  EpiG1 E; E.Z = (u16*)(p.ws + OFF_RB); E.ux = (u16*)(p.ws + OFF_RC); E.gg = E.ux + (size_t)NT * 512;
  pg8::gemm_phase<EpiG1, pg8::StaticOrder, false>((PG8_LAS unsigned char*)smem, g, S, E, nullptr);
}
__device__ void phase_gemm2(const Params& p, char* smem) {
  pg8::Gemm g; g.A = (const u16*)(p.ws + OFF_RB); g.Bt = (const u16*)(p.ws + OFF_W2T); g.M = NT; g.N = 1024; g.K = D;
  pg8::StaticOrder S; S.init(NT, 1024, gridDim.x, blockIdx.x);
  EpiG2 E; E.xp = p.x_prompt; E.xs = p.x_sample; E.mod = (const float*)(p.ws + OFF_MOD); E.out = p.out;
  pg8::gemm_phase<EpiG2, pg8::StaticOrder, false>((PG8_LAS unsigned char*)smem, g, S, E, nullptr);
}
__device__ void phase_gemm3(const Params& p, char* smem) {
  pg8::Gemm g; g.A = (const u16*)(p.ws + OFF_RA); g.Bt = (const u16*)(p.ws + OFF_WQT); g.M = NT; g.N = 2048; g.K = D;
  pg8::StaticOrder S; S.init(NT, 2048, gridDim.x, blockIdx.x);
  EpiG3 E; E.q = (u16*)(p.ws + OFF_RC);
  pg8::gemm_phase<EpiG3, pg8::StaticOrder, false>((PG8_LAS unsigned char*)smem, g, S, E, nullptr);
}

__device__ void phase_fft1(const Params& p, char* smem) {
  const u16* Z = (const u16*)(p.ws + OFF_RB);
  const u16* A1 = (const u16*)(p.ws + OFF_A1);
  u16* Tb = (u16*)(p.ws + OFF_RA);
  const int half = threadIdx.x >> 8, htid = threadIdx.x & 255;
  smem += half * SMEM_GEMM;
  for (int tile0 = blockIdx.x * 2; tile0 < 3072; tile0 += gridDim.x * 2) {
    const int tile = tile0 + half;
    const int mtile = tile & 1, chb = (tile >> 1) & 3, s2 = (tile >> 3) & 127, b = tile >> 10;
    const u16* Zb = Z + ((size_t)b * SEQ + s2) * 1024 + chb * 128;
    auto arow = [&](int r) { return A1 + (size_t)(mtile * 128 + r) * 256; };
    auto brow = [&](int k) { return Zb + (size_t)(k & 127) * (128 * 1024) + (k >> 7) * 512; };
    u16* To = Tb + (((size_t)b * 128) * 128 + s2) * 1024 + mtile * 512 + chb * 128;
    gemm_tile<1>(arow, brow, 256, [&](int r, int c, float v) { To[(size_t)r * (128 * 1024) + c] = (u16)f2bf(v); }, smem, htid);
  }
}

__device__ void phase_fold(const Params& p, char* smem) {
  const u16* wqb = (const u16*)(p.ws + OFF_UB + (20ull << 20));
  u16* wqT = (u16*)(p.ws + OFF_WQT);
  const int half = threadIdx.x >> 8, htid = threadIdx.x & 255;
  smem += half * SMEM_GEMM;
  for (int tile0 = blockIdx.x * 2; tile0 < 128; tile0 += gridDim.x * 2) {
    const int tile = tile0 + half;
    const int hh = tile >> 3, nt = tile & 7;
    const u16* keys = (const u16*)(p.ws + ((hh & 1) ? OFF_K2B : OFF_K1B)) + (size_t)(hh >> 1) * 16384;
    auto arow = [&](int r) { return keys + (size_t)r * 128; };
    auto brow = [&](int r) { return wqb + (size_t)(nt * 128 + r) * 2048 + hh * 128; };
    u16* o = wqT + (size_t)(hh * 128) * 1024 + nt * 128;
    gemm_tile<0>(arow, brow, 128, [&](int r, int c, float v) { o[(size_t)r * 1024 + c] = (u16)f2bf(v); }, smem, htid);
  }
}

constexpr int XP = 68;
constexpr int SMEM_LRU = 64 * XP * 4 + 2 * 64 * 64 * 4 + 2048;
#define LDS_BARRIER() asm volatile("s_waitcnt lgkmcnt(0)\n\ts_barrier" ::: "memory")
__device__ void phase_lru_local(const Params& p, char* smem) {
  const int half = threadIdx.x >> 8;
  smem += half * SMEM_LRU;
  float* sX = (float*)smem;
  float* sAa = sX + 64 * XP;
  float* sBb = sAa + 64 * 64;
  u16* stg = (u16*)sAa;
  const int tid = threadIdx.x & 255, lane = tid & 63, w = tid >> 6;
  const u16* ux = (const u16*)(p.ws + OFF_RC);
  const u16* waT = (const u16*)(p.ws + OFF_WAT);
  float* sumP = (float*)(p.ws + OFF_SUMP);
  float* sumH = (float*)(p.ws + OFF_SUMH);
  const float* clt = (const float*)(p.ws + OFF_MOD + (128ull << 10));
  float* sSeg = sBb + 64 * 64;
  u16* HP = (u16*)p.out;
  u32x4 sreg[3];
#define LRU_STG_LOAD(tile_)                                                                                  \
  {                                                                                                          \
    const int h_ = (tile_) & 7, c_ = ((tile_) >> 3) & (NCH - 1), b_ = (tile_) >> 11;                         \
    _Pragma("unroll") for (int i = 0; i < 3; ++i) {                                                          \
      const int idx = tid + 256 * i;                                                                         \
      sreg[i] = (u32x4){0u, 0u, 0u, 0u};                                                                     \
      if (idx < 67 * 8) {                                                                                    \
        const int r = idx >> 3, c8 = idx & 7, t = c_ * 64 - 2 + r;                                           \
        if (t >= 0 && t < SEQ) sreg[i] = *(const u32x4*)(ux + ((size_t)b_ * SEQ + t) * 512 + h_ * 64 + c8 * 8); \
      }                                                                                                      \
    }                                                                                                        \
  }
  if (blockIdx.x * 2 < NSEQ * NCH * 8) LRU_STG_LOAD(blockIdx.x * 2 + half)
  for (int tile0 = blockIdx.x * 2; tile0 < NSEQ * NCH * 8; tile0 += gridDim.x * 2) {
    const int tile = tile0 + half;
    const int h = tile & 7, c = (tile >> 3) & (NCH - 1), b = tile >> 11;
    const int T0 = b * SEQ + c * 64;
    LDS_BARRIER();
#pragma unroll
    for (int i = 0; i < 3; ++i) {
      const int idx = tid + 256 * i;
      if (idx < 67 * 8) *(u32x4*)(stg + (idx >> 3) * 64 + (idx & 7) * 8) = sreg[i];
    }
    if (tile0 + gridDim.x * 2 < NSEQ * NCH * 8) LRU_STG_LOAD(tile + gridDim.x * 2)
    bf16x8 bw[2][4][2];
#define LRU_W_LOAD(d_)                                                                                        \
  _Pragma("unroll") for (int g = 0; g < 2; ++g)                                                               \
    _Pragma("unroll") for (int nt = 0; nt < 4; ++nt)                                                          \
      _Pragma("unroll") for (int kk = 0; kk < 2; ++kk)                                                        \
        bw[g][nt][kk] = *(const bf16x8*)(waT + ((size_t)(((d_) * 2 + g) * 8 + h) * 64 + nt * 16 + (lane & 15)) * 64 + kk * 32 + (lane >> 4) * 8);
    LRU_W_LOAD(0)
    LDS_BARRIER();
    {
      const int ch = tid & 63, chg = h * 64 + ch;
      const float w0 = p.conv_w[chg], w1 = p.conv_w[512 + chg], w2 = p.conv_w[1024 + chg], w3 = p.conv_w[1536 + chg];
      const float cb = p.conv_b[chg];
#pragma unroll 4
      for (int i = 0; i < 16; ++i) {
        int t = (tid >> 6) + 4 * i;
        float v = cb + w0 * __uint_as_float((unsigned)stg[t * 64 + ch] << 16) + w1 * __uint_as_float((unsigned)stg[(t + 1) * 64 + ch] << 16)
                + w2 * __uint_as_float((unsigned)stg[(t + 2) * 64 + ch] << 16) + w3 * __uint_as_float((unsigned)stg[(t + 3) * 64 + ch] << 16);
        sX[t * XP + ch] = v;
      }
    }
    LDS_BARRIER();
    bf16x8 af[2];
#pragma unroll
    for (int kk = 0; kk < 2; ++kk) {
      const float* src = sX + (16 * w + (lane & 15)) * XP + kk * 32 + (lane >> 4) * 8;
      float4 f0 = *(const float4*)src, f1 = *(const float4*)(src + 4);
      u32x4 pk = (u32x4){pack2(f0.x, f0.y), pack2(f0.z, f0.w), pack2(f1.x, f1.y), pack2(f1.z, f1.w)};
      af[kk] = __builtin_bit_cast(bf16x8, pk);
    }
    float hkeep[2][8];
#pragma unroll
    for (int d = 0; d < 2; ++d) {
      f32x4 acc[2][4];
#pragma unroll
      for (int g = 0; g < 2; ++g)
#pragma unroll
        for (int nt = 0; nt < 4; ++nt) {
          acc[g][nt] = (f32x4){0.f, 0.f, 0.f, 0.f};
#pragma unroll
          for (int kk = 0; kk < 2; ++kk)
            acc[g][nt] = __builtin_amdgcn_mfma_f32_16x16x32_bf16(af[kk], bw[g][nt][kk], acc[g][nt], 0, 0, 0);
        }
      if (d == 0) { LRU_W_LOAD(1) }
#pragma unroll
      for (int nt = 0; nt < 4; ++nt) {
        const int ch = nt * 16 + (lane & 15), chg = h * 64 + ch;
        const float ba = p.lru_ba[d * 512 + chg], bx = p.lru_bx[d * 512 + chg];
        const float cl = clt[d * 512 + chg];
#pragma unroll
        for (int j = 0; j < 4; ++j) {
          const int tok = 16 * w + 4 * (lane >> 4) + j;
          float r = sigmoidf_(acc[0][nt][j] + ba);
          float ii = sigmoidf_(acc[1][nt][j] + bx);
          float a = __expf(cl * r);
          float bb = __builtin_amdgcn_sqrtf(fmaxf(1.f - a * a, 0.f)) * ii * sX[tok * XP + ch];
          sAa[tok * 64 + ch] = a; sBb[tok * 64 + ch] = bb;
        }
      }
      LDS_BARRIER();
      {
        const int ch = tid & 63, seg = tid >> 6;
        float av[16], bv[16];
#pragma unroll
        for (int u = 0; u < 16; ++u) {
          const int t = d ? 63 - (seg * 16 + u) : seg * 16 + u;
          av[u] = sAa[t * 64 + ch]; bv[u] = sBb[t * 64 + ch];
        }
        float hh = 0.f, P = 1.f;
#pragma unroll
        for (int u = 0; u < 16; ++u) { hh = av[u] * hh + bv[u]; P *= av[u]; bv[u] = hh; av[u] = P; }
        sSeg[(seg * 64 + ch) * 2 + 0] = P; sSeg[(seg * 64 + ch) * 2 + 1] = hh;
        LDS_BARRIER();
        float cin = 0.f, Pin = 1.f;
        for (int s2 = 0; s2 < seg; ++s2) {
          const float Ps = sSeg[(s2 * 64 + ch) * 2 + 0], Hs = sSeg[(s2 * 64 + ch) * 2 + 1];
          cin = Ps * cin + Hs; Pin *= Ps;
        }
#pragma unroll
        for (int u = 0; u < 16; ++u) {
          const int t = d ? 63 - (seg * 16 + u) : seg * 16 + u;
          sBb[t * 64 + ch] = bv[u] + av[u] * cin; sAa[t * 64 + ch] = av[u] * Pin;
        }
        if (seg == 3) {
          size_t si = ((size_t)(b * NCH + c) * 2 + d) * 512 + h * 64 + ch;
          sumP[si] = av[15] * Pin; sumH[si] = bv[15] + av[15] * cin;
        }
      }
      LDS_BARRIER();
      u16* Hd = HP;
      u16* Pd = HP + (size_t)(d * 2 + 1) * NT * 512;
#pragma unroll
      for (int i = 0; i < 2; ++i) {
        int idx = tid + 256 * i; int t = idx >> 3, c8 = idx & 7;
        const float* hs = sBb + t * 64 + c8 * 8; const float* ps = sAa + t * 64 + c8 * 8;
        size_t o = (size_t)(T0 + t) * 512 + h * 64 + c8 * 8;
        if (d == 0) {
#pragma unroll
          for (int j = 0; j < 8; ++j) hkeep[i][j] = hs[j];
        } else {
          *(uint4*)(Hd + o) = make_uint4(pack2(hs[0] + hkeep[i][0], hs[1] + hkeep[i][1]), pack2(hs[2] + hkeep[i][2], hs[3] + hkeep[i][3]),
                                        pack2(hs[4] + hkeep[i][4], hs[5] + hkeep[i][5]), pack2(hs[6] + hkeep[i][6], hs[7] + hkeep[i][7]));
        }
        *(uint4*)(Pd + o) = make_uint4(pack2(ps[0], ps[1]), pack2(ps[2], ps[3]), pack2(ps[4], ps[5]), pack2(ps[6], ps[7]));
      }
      LDS_BARRIER();
    }
  }
}

__device__ void phase_carry(const Params& p, char* smem) {
  const float* sumP = (const float*)(p.ws + OFF_SUMP);
  const float* sumH = (const float*)(p.ws + OFF_SUMH);
  float* carry = (float*)(p.ws + OFF_CARRY);
  float* sS = (float*)smem;
  const int tid = threadIdx.x, cl = tid & 31, seg = tid >> 5;
  for (int blk = blockIdx.x; blk < 96; blk += gridDim.x) {
    const int gid = blk * 32 + cl;
    const int chg = gid & 511, d = (gid >> 9) & 1, b = gid >> 10;
    float Pv[16], Hv[16];
#pragma unroll
    for (int u = 0; u < 16; ++u) {
      const int pos = seg * 16 + u, c = d ? (NCH - 1 - pos) : pos;
      const size_t si = ((size_t)(b * NCH + c) * 2 + d) * 512 + chg;
      Pv[u] = sumP[si]; Hv[u] = sumH[si];
    }
    float cin = 0.f, Pacc = 1.f;
#pragma unroll
    for (int u = 0; u < 16; ++u) {
      const float Pu = Pv[u], Hu = Hv[u];
      Hv[u] = cin; Pv[u] = Pacc;
      cin = Pu * cin + Hu; Pacc *= Pu;
    }
    sS[(seg * 32 + cl) * 2 + 0] = Pacc; sS[(seg * 32 + cl) * 2 + 1] = cin;
    __syncthreads();
    float cs = 0.f;
    for (int s2 = 0; s2 < seg; ++s2) cs = sS[(s2 * 32 + cl) * 2 + 0] * cs + sS[(s2 * 32 + cl) * 2 + 1];
#pragma unroll
    for (int u = 0; u < 16; ++u) {
      const int pos = seg * 16 + u, c = d ? (NCH - 1 - pos) : pos;
      const size_t si = ((size_t)(b * NCH + c) * 2 + d) * 512 + chg;
      carry[si] = Hv[u] + Pv[u] * cs;
    }
    __syncthreads();
  }
}

__device__ void phase_fft3(const Params& p, char* smem) {
  const u16* Tb = (const u16*)(p.ws + OFF_RA);
  const u16* Mt = (const u16*)(p.ws + OFF_MTAB);
  u16* Y = (u16*)(p.ws + OFF_RB);
  const int half = threadIdx.x >> 8, htid = threadIdx.x & 255;
  smem += half * SMEM_GEMM;
  for (int tile0 = blockIdx.x * 2; tile0 < 1536; tile0 += gridDim.x * 2) {
    const int tile = tile0 + half;
    const int chb = tile & 3, k1 = (tile >> 2) & 127, b = tile >> 9;
    const u16* Tk = Tb + ((size_t)(b * 128 + k1) * 128) * 1024 + chb * 128;
    auto arow = [&](int r) { return Mt + ((size_t)k1 * 128 + r) * 256; };
    auto brow = [&](int k) { return Tk + (size_t)(k & 127) * 1024 + (k >> 7) * 512; };
    u16* Yo = Y + ((size_t)b * SEQ + k1) * 1024 + chb * 128;
    gemm_tile<1>(arow, brow, 256, [&](int r, int c, float v) { Yo[(size_t)r * (128 * 1024) + c] = (u16)f2bf(v); }, smem, htid);
  }
}

__device__ void phase_lru_fix(const Params& p) {
  const u16* HP = (const u16*)p.out;
  const u16* gg = (const u16*)(p.ws + OFF_RC) + (size_t)NT * 512;
  const float* carry = (const float*)(p.ws + OFF_CARRY);
  u16* Y = (u16*)(p.ws + OFF_RB);
  const size_t gtid = (size_t)blockIdx.x * 512 + threadIdx.x, gstride = (size_t)gridDim.x * 512;
  for (size_t idx = gtid; idx < (size_t)NT * 64; idx += gstride) {
    const int T = (int)(idx >> 6), ch0 = (int)(idx & 63) * 8;
    const int b = T >> 14, c = (T & (SEQ - 1)) >> 6;
    const size_t o = (size_t)T * 512 + ch0;
    uint4 hf = *(const uint4*)(HP + o), pf = *(const uint4*)(HP + (size_t)NT * 512 + o);
    uint4 pr = *(const uint4*)(HP + (size_t)3 * NT * 512 + o);
    uint4 g = *(const uint4*)(gg + o);
    const float* cf = carry + ((size_t)(b * NCH + c) * 2 + 0) * 512 + ch0;
    const float* cr = carry + ((size_t)(b * NCH + c) * 2 + 1) * 512 + ch0;
    float4 cf0 = *(const float4*)cf, cf1 = *(const float4*)(cf + 4), cr0 = *(const float4*)cr, cr1 = *(const float4*)(cr + 4);
    float y0 = (bflo(hf.x) + bflo(pf.x) * cf0.x + bflo(pr.x) * cr0.x) * bflo(g.x);
    float y1 = (bfhi(hf.x) + bfhi(pf.x) * cf0.y + bfhi(pr.x) * cr0.y) * bfhi(g.x);
    float y2 = (bflo(hf.y) + bflo(pf.y) * cf0.z + bflo(pr.y) * cr0.z) * bflo(g.y);
    float y3 = (bfhi(hf.y) + bfhi(pf.y) * cf0.w + bfhi(pr.y) * cr0.w) * bfhi(g.y);
    float y4 = (bflo(hf.z) + bflo(pf.z) * cf1.x + bflo(pr.z) * cr1.x) * bflo(g.z);
    float y5 = (bfhi(hf.z) + bfhi(pf.z) * cf1.y + bfhi(pr.z) * cr1.y) * bfhi(g.z);
    float y6 = (bflo(hf.w) + bflo(pf.w) * cf1.z + bflo(pr.w) * cr1.z) * bflo(g.w);
    float y7 = (bfhi(hf.w) + bfhi(pf.w) * cf1.w + bfhi(pr.w) * cr1.w) * bfhi(g.w);
    *(uint4*)(Y + (size_t)T * 1024 + 512 + ch0) = make_uint4(pack2(y0, y1), pack2(y2, y3), pack2(y4, y5), pack2(y6, y7));
  }
}

template <int N>
__device__ __forceinline__ void bitonic_sort_desc(float (&v)[N]) {
#pragma unroll
  for (int k = 2; k <= N; k <<= 1) {
#pragma unroll
    for (int j = k >> 1; j > 0; j >>= 1) {
#pragma unroll
      for (int i = 0; i < N; ++i) {
        const int l = i ^ j;
        if (l > i) {
          const bool desc = ((i & k) == 0);
          float mx = fmaxf(v[i], v[l]), mn = fminf(v[i], v[l]);
          v[i] = desc ? mx : mn; v[l] = desc ? mn : mx;
        }
      }
    }
  }
}
template <int N>
__device__ __forceinline__ void bitonic_merge_desc(float (&v)[N]) {
#pragma unroll
  for (int j = N >> 1; j > 0; j >>= 1) {
#pragma unroll
    for (int i = 0; i < N; ++i) {
      const int l = i ^ j;
      if (l > i) { float mx = fmaxf(v[i], v[l]), mn = fminf(v[i], v[l]); v[i] = mx; v[l] = mn; }
    }
  }
}
__device__ __forceinline__ void top16_of_64(const float (&v)[64], float (&top)[16]) {
#pragma unroll
  for (int i = 0; i < 16; ++i) top[i] = v[i];
  bitonic_sort_desc<16>(top);
#pragma unroll
  for (int g = 1; g < 4; ++g) {
    float blk[16];
#pragma unroll
    for (int i = 0; i < 16; ++i) blk[i] = v[16 * g + i];
    bitonic_sort_desc<16>(blk);
#pragma unroll
    for (int i = 0; i < 16; ++i) top[i] = fmaxf(top[i], blk[15 - i]);
    bitonic_merge_desc<16>(top);
  }
}

__device__ __forceinline__ void score_top16(const u16* __restrict__ sp, int lane, float (&top)[16]) {
  const int hi = lane >> 5;
  u32x4 raw[8];
#pragma unroll
  for (int i = 0; i < 8; ++i) raw[i] = *(const u32x4*)(sp + i * 8);
  float v[64];
#pragma unroll
  for (int i = 0; i < 8; ++i)
#pragma unroll
    for (int j = 0; j < 4; ++j) {
      const unsigned key0 = 64 * hi + i * 8 + 2 * j;
      v[i * 8 + 2 * j] = __uint_as_float((raw[i][j] << 16) | key0);
      v[i * 8 + 2 * j + 1] = __uint_as_float((raw[i][j] & 0xFFFF0000u) | (key0 + 1));
    }
  top16_of_64(v, top);
  float t[16];
#pragma unroll
  for (int i = 0; i < 16; ++i) t[i] = __shfl_xor(top[i], 32);
#pragma unroll
  for (int i = 0; i < 16; ++i) top[i] = fmaxf(top[i], t[15 - i]);
  bitonic_merge_desc<16>(top);
}

__device__ __forceinline__ void top16_of_50(const float (&v)[64], float (&top)[16]) {
#pragma unroll
  for (int i = 0; i < 16; ++i) top[i] = v[i];
  bitonic_sort_desc<16>(top);
#pragma unroll
  for (int g = 1; g < 3; ++g) {
    float blk[16];
#pragma unroll
    for (int i = 0; i < 16; ++i) blk[i] = v[16 * g + i];
    bitonic_sort_desc<16>(blk);
#pragma unroll
    for (int i = 0; i < 16; ++i) top[i] = fmaxf(top[i], blk[15 - i]);
    bitonic_merge_desc<16>(top);
  }
  const float hi2 = fmaxf(v[48], v[49]), lo2 = fminf(v[48], v[49]);
  top[15] = fmaxf(top[15], hi2);
  top[14] = fmaxf(top[14], lo2);
  bitonic_merge_desc<16>(top);
}

__device__ void phase_topk(const Params& p) {
  const int lane = threadIdx.x & 63;
  const int gw = blockIdx.x * 8 + (threadIdx.x >> 6), nw = gridDim.x * 8;
  const u16* q = (const u16*)(p.ws + OFF_RC);
  const u16* k1b = (const u16*)(p.ws + OFF_K1B);
  const u16* k2b = (const u16*)(p.ws + OFF_K2B);
  uint4* eg = (uint4*)(p.ws + OFF_RB);
  for (int item = gw; item < (NT / 32) * 8; item += nw) {
    const int h = item & 7, grp = item >> 3;
    const int T = grp * 32 + (lane & 31);
    const u16* qp = q + (size_t)T * 2048 + h * 256 + (lane >> 5) * 64;
    float t1[16], t2[16];
    score_top16(qp, lane, t1);
    score_top16(qp + 128, lane, t2);
    float cand[64];
#pragma unroll
    for (int i = 0; i < 64; ++i) cand[i] = -3.0e38f;
    {
      int n = 0;
#pragma unroll
      for (int a = 0; a < 16; ++a) {
#pragma unroll
        for (int bb = 0; bb < 16; ++bb) {
          if ((a + 1) * (bb + 1) <= 16) {
            unsigned ia = __float_as_uint(t1[a]) & 127u, ib = __float_as_uint(t2[bb]) & 127u;
            float s = t1[a] + t2[bb];
            cand[n] = __uint_as_float((__float_as_uint(s) & ~16383u) | (ia << 7) | ib);
            ++n;
          }
        }
      }
    }
    float top[16];
    top16_of_50(cand, top);
    float wgt[16]; float mx, sum = 0.f;
    mx = __uint_as_float(__float_as_uint(top[0]) & ~16383u);
#pragma unroll
    for (int i = 0; i < 16; ++i) { wgt[i] = __expf(__uint_as_float(__float_as_uint(top[i]) & ~16383u) - mx); sum += wgt[i]; }
    const float inv = 1.f / sum;
    if (lane < 32) {
      {
        u32x4* d16 = (u32x4*)(p.ws + OFF_RB + (48ull << 20)) + ((size_t)T * 8 + h) * 2;
        u32x4 w0, w1;
        w0[0] = (__float_as_uint(top[0]) & 16383u) | ((__float_as_uint(top[1]) & 16383u) << 16);
        w0[1] = (__float_as_uint(top[2]) & 16383u) | ((__float_as_uint(top[3]) & 16383u) << 16);
        w0[2] = (__float_as_uint(top[4]) & 16383u) | ((__float_as_uint(top[5]) & 16383u) << 16);
        w0[3] = (__float_as_uint(top[6]) & 16383u) | ((__float_as_uint(top[7]) & 16383u) << 16);
        w1[0] = (__float_as_uint(top[8]) & 16383u) | ((__float_as_uint(top[9]) & 16383u) << 16);
        w1[1] = (__float_as_uint(top[10]) & 16383u) | ((__float_as_uint(top[11]) & 16383u) << 16);
        w1[2] = (__float_as_uint(top[12]) & 16383u) | ((__float_as_uint(top[13]) & 16383u) << 16);
        w1[3] = (__float_as_uint(top[14]) & 16383u) | ((__float_as_uint(top[15]) & 16383u) << 16);
        d16[0] = w0; d16[1] = w1;
      }
      uint4* dst = eg + ((size_t)T * 8 + h) * 8;
#pragma unroll
      for (int i = 0; i < 8; ++i) {
        dst[i] = make_uint4(__float_as_uint(top[2 * i]) & 16383u, __float_as_uint(wgt[2 * i] * inv),
                            __float_as_uint(top[2 * i + 1]) & 16383u, __float_as_uint(wgt[2 * i + 1] * inv));
      }
    }
  }
}

#define CVT8(w_, hi_) __builtin_amdgcn_cvt_pk_f32_fp8((int)(w_), hi_)
__device__ void phase_peer(const Params& p) {
  const int lane = threadIdx.x & 63;
  const int gw = blockIdx.x * 8 + (threadIdx.x >> 6), nw = gridDim.x * 8;
  const u16* h2 = (const u16*)(p.ws + OFF_RA);
  const char* ub8 = p.ws + OFF_UB + lane * 16;
  const char* vb8 = p.ws + OFF_VB + lane * 16;
  const float* su = (const float*)(p.ws + OFF_UB + (16ull << 20));
  const float* sv = (const float*)(p.ws + OFF_VB + (16ull << 20));
  const uint2* eg = (const uint2*)(p.ws + OFF_RB);
  const float* mod = (const float*)(p.ws + OFF_MOD);
  if (gw >= NT) return;
  uint2 eAn = eg[(size_t)gw * 128 + lane], eBn = eg[(size_t)gw * 128 + 64 + lane];
  u32x4 hAn = *(const u32x4*)(h2 + (size_t)gw * D + lane * 16), hBn = *(const u32x4*)(h2 + (size_t)gw * D + lane * 16 + 8);
  u32x4 ubuf[16], vbuf[16];
#pragma unroll
  for (int k = 0; k < 16; ++k) {
    const int e = __builtin_amdgcn_readlane((int)eAn.x, k);
    ubuf[k] = *(const u32x4*)(ub8 + (size_t)e * 1024);
  }
  for (int T = gw; T < NT; T += nw) {
    const int seq = T >> 14;
    const uint2 eA = eAn, eB = eBn;
    f32x2 hf[8];
    hf[0] = (f32x2){bflo(hAn[0]), bfhi(hAn[0])}; hf[1] = (f32x2){bflo(hAn[1]), bfhi(hAn[1])};
    hf[2] = (f32x2){bflo(hAn[2]), bfhi(hAn[2])}; hf[3] = (f32x2){bflo(hAn[3]), bfhi(hAn[3])};
    hf[4] = (f32x2){bflo(hBn[0]), bfhi(hBn[0])}; hf[5] = (f32x2){bflo(hBn[1]), bfhi(hBn[1])};
    hf[6] = (f32x2){bflo(hBn[2]), bfhi(hBn[2])}; hf[7] = (f32x2){bflo(hBn[3]), bfhi(hBn[3])};
    const float suA = su[eA.x], suB = su[eB.x];
    const float gsA = __uint_as_float(eA.y) * sv[eA.x], gsB = __uint_as_float(eB.y) * sv[eB.x];
    {
      const int Tn = (T + nw < NT) ? T + nw : T;
      eAn = eg[(size_t)Tn * 128 + lane]; eBn = eg[(size_t)Tn * 128 + 64 + lane];
      hAn = *(const u32x4*)(h2 + (size_t)Tn * D + lane * 16); hBn = *(const u32x4*)(h2 + (size_t)Tn * D + lane * 16 + 8);
    }
    f32x2 o[8];
#pragma unroll
    for (int i = 0; i < 8; ++i) o[i] = (f32x2){0.f, 0.f};
#pragma unroll 1
    for (int h = 0; h < 8; ++h) {
      const int ecur = (h < 4) ? (int)eA.x : (int)eB.x;
      const int base = (h & 3) * 16;
#pragma unroll
      for (int k = 0; k < 16; ++k) {
        const int e = __builtin_amdgcn_readlane(ecur, base + k);
        vbuf[k] = *(const u32x4*)(vb8 + (size_t)e * 1024);
      }
      float acc[16];
#pragma unroll
      for (int k = 0; k < 16; ++k) {
        const u32x4 a = ubuf[k];
        f32x2 s2 = hf[0] * CVT8(a[0], false);
        s2 = __builtin_elementwise_fma(hf[1], CVT8(a[0], true), s2);
        s2 = __builtin_elementwise_fma(hf[2], CVT8(a[1], false), s2);
        s2 = __builtin_elementwise_fma(hf[3], CVT8(a[1], true), s2);
        s2 = __builtin_elementwise_fma(hf[4], CVT8(a[2], false), s2);
        s2 = __builtin_elementwise_fma(hf[5], CVT8(a[2], true), s2);
        s2 = __builtin_elementwise_fma(hf[6], CVT8(a[3], false), s2);
        s2 = __builtin_elementwise_fma(hf[7], CVT8(a[3], true), s2);
        acc[k] = s2.x + s2.y;
      }
      {
        const int enx = (h < 3) ? (int)eA.x : ((h < 7) ? (int)eB.x : (int)eAn.x);
        const int base1 = ((h + 1) & 3) * 16;
#pragma unroll
        for (int k = 0; k < 16; ++k) {
          const int e = __builtin_amdgcn_readlane(enx, base1 + k);
          ubuf[k] = *(const u32x4*)(ub8 + (size_t)e * 1024);
        }
      }
      float a8[8], a4[4], a2[2], tot;
      {
        const bool up = (lane & 32) != 0;
#pragma unroll
        for (int i = 0; i < 8; ++i) { float send = up ? acc[i] : acc[i + 8]; float keep = up ? acc[i + 8] : acc[i]; a8[i] = keep + __shfl_xor(send, 32); }
      }
      {
        const bool up = (lane & 16) != 0;
#pragma unroll
        for (int i = 0; i < 4; ++i) { float send = up ? a8[i] : a8[i + 4]; float keep = up ? a8[i + 4] : a8[i]; a4[i] = keep + __shfl_xor(send, 16); }
      }
      {
        const bool up = (lane & 8) != 0;
#pragma unroll
        for (int i = 0; i < 2; ++i) { float send = up ? a4[i] : a4[i + 2]; float keep = up ? a4[i + 2] : a4[i]; a2[i] = keep + __shfl_xor(send, 8); }
      }
      {
        const bool up = (lane & 4) != 0;
        float send = up ? a2[0] : a2[1]; float keep = up ? a2[1] : a2[0]; tot = keep + __shfl_xor(send, 4);
      }
      tot += __shfl_xor(tot, 2);
      tot += __shfl_xor(tot, 1);
      const float sucur = (h < 4) ? suA : suB;
      const float gscur = (h < 4) ? gsA : gsB;
      const float suk = __shfl(sucur, base + (lane >> 2));
      const float gsk = __shfl(gscur, base + (lane >> 2));
      const float coef = gsk * gelu_tanh(suk * tot);
      const int coefb = (int)__float_as_uint(coef);
#pragma unroll
      for (int k = 0; k < 16; ++k) {
        const float ck = __uint_as_float((unsigned)__builtin_amdgcn_readlane(coefb, 4 * k));
        const f32x2 ck2 = (f32x2){ck, ck};
        const u32x4 a = vbuf[k];
        o[0] = __builtin_elementwise_fma(ck2, CVT8(a[0], false), o[0]);
        o[1] = __builtin_elementwise_fma(ck2, CVT8(a[0], true), o[1]);
        o[2] = __builtin_elementwise_fma(ck2, CVT8(a[1], false), o[2]);
        o[3] = __builtin_elementwise_fma(ck2, CVT8(a[1], true), o[3]);
        o[4] = __builtin_elementwise_fma(ck2, CVT8(a[2], false), o[4]);
        o[5] = __builtin_elementwise_fma(ck2, CVT8(a[2], true), o[5]);
        o[6] = __builtin_elementwise_fma(ck2, CVT8(a[3], false), o[6]);
        o[7] = __builtin_elementwise_fma(ck2, CVT8(a[3], true), o[7]);
      }
    }
    float* xo = p.out + (size_t)T * D + lane * 16;
    const float* g2 = mod + seq * 6144 + 5120 + lane * 16;
    const float* nf = p.norm_f_g + lane * 16;
    float4 x2[4]; float ss = 0.f;
#pragma unroll
    for (int i = 0; i < 4; ++i) {
      float4 xa = *(const float4*)(xo + 4 * i), ga = *(const float4*)(g2 + 4 * i);
      x2[i].x = xa.x + ga.x * o[2 * i].x; x2[i].y = xa.y + ga.y * o[2 * i].y;
      x2[i].z = xa.z + ga.z * o[2 * i + 1].x; x2[i].w = xa.w + ga.w * o[2 * i + 1].y;
      ss += x2[i].x * x2[i].x + x2[i].y * x2[i].y + x2[i].z * x2[i].z + x2[i].w * x2[i].w;
    }
    ss = wave_sum(ss);
    const float rstd = rsqrtf(ss * (1.f / 1024.f) + 1e-6f);
#pragma unroll
    for (int i = 0; i < 4; ++i) {
      float4 na = *(const float4*)(nf + 4 * i);
      *(float4*)(xo + 4 * i) = make_float4(x2[i].x * rstd * na.x, x2[i].y * rstd * na.y, x2[i].z * rstd * na.z, x2[i].w * rstd * na.w);
    }
  }
}

__device__ void phase_peer_u_tm(const Params& p) {
  const int lane = threadIdx.x & 63;
  const int gw = blockIdx.x * 8 + (threadIdx.x >> 6), nw = gridDim.x * 8;
  const u16* h2 = (const u16*)(p.ws + OFF_RA);
  const char* ub8 = p.ws + OFF_UB + lane * 16;
  const char* vb8 = p.ws + OFF_VB + lane * 16;
  const float* su = (const float*)(p.ws + OFF_UB + (16ull << 20));
  const float* sv = (const float*)(p.ws + OFF_VB + (16ull << 20));
  const uint2* eg = (const uint2*)(p.ws + OFF_RB);
  const float* mod = (const float*)(p.ws + OFF_MOD);
  if (gw >= NT) return;
  uint2 eAn = eg[(size_t)gw * 128 + lane], eBn = eg[(size_t)gw * 128 + 64 + lane];
  u32x4 hAn = *(const u32x4*)(h2 + (size_t)gw * D + lane * 16), hBn = *(const u32x4*)(h2 + (size_t)gw * D + lane * 16 + 8);
  u32x4 ubuf[16];
  float* coefbuf = (float*)(p.ws + OFF_RB + (64ull << 20));
#pragma unroll
  for (int k = 0; k < 16; ++k) {
    const int e = __builtin_amdgcn_readlane((int)eAn.x, k);
    ubuf[k] = *(const u32x4*)(ub8 + (size_t)e * 1024);
  }
  for (int T = gw; T < NT; T += nw) {
    const int seq = T >> 14;
    const uint2 eA = eAn, eB = eBn;
    f32x2 hf[8];
    hf[0] = (f32x2){bflo(hAn[0]), bfhi(hAn[0])}; hf[1] = (f32x2){bflo(hAn[1]), bfhi(hAn[1])};
    hf[2] = (f32x2){bflo(hAn[2]), bfhi(hAn[2])}; hf[3] = (f32x2){bflo(hAn[3]), bfhi(hAn[3])};
    hf[4] = (f32x2){bflo(hBn[0]), bfhi(hBn[0])}; hf[5] = (f32x2){bflo(hBn[1]), bfhi(hBn[1])};
    hf[6] = (f32x2){bflo(hBn[2]), bfhi(hBn[2])}; hf[7] = (f32x2){bflo(hBn[3]), bfhi(hBn[3])};
    const float suA = su[eA.x], suB = su[eB.x];
    const float gsA = __uint_as_float(eA.y) * sv[eA.x], gsB = __uint_as_float(eB.y) * sv[eB.x];
    {
      const int Tn = (T + nw < NT) ? T + nw : T;
      eAn = eg[(size_t)Tn * 128 + lane]; eBn = eg[(size_t)Tn * 128 + 64 + lane];
      hAn = *(const u32x4*)(h2 + (size_t)Tn * D + lane * 16); hBn = *(const u32x4*)(h2 + (size_t)Tn * D + lane * 16 + 8);
    }
#pragma unroll 1
    for (int h = 0; h < 8; ++h) {
      const int ecur = (h < 4) ? (int)eA.x : (int)eB.x;
      const int base = (h & 3) * 16;
      float acc[16];
#pragma unroll
      for (int k = 0; k < 16; ++k) {
        const u32x4 a = ubuf[k];
        f32x2 s2 = hf[0] * CVT8(a[0], false);
        s2 = __builtin_elementwise_fma(hf[1], CVT8(a[0], true), s2);
        s2 = __builtin_elementwise_fma(hf[2], CVT8(a[1], false), s2);
        s2 = __builtin_elementwise_fma(hf[3], CVT8(a[1], true), s2);
        s2 = __builtin_elementwise_fma(hf[4], CVT8(a[2], false), s2);
        s2 = __builtin_elementwise_fma(hf[5], CVT8(a[2], true), s2);
        s2 = __builtin_elementwise_fma(hf[6], CVT8(a[3], false), s2);
        s2 = __builtin_elementwise_fma(hf[7], CVT8(a[3], true), s2);
        acc[k] = s2.x + s2.y;
      }
      {
        const int enx = (h < 3) ? (int)eA.x : ((h < 7) ? (int)eB.x : (int)eAn.x);
        const int base1 = ((h + 1) & 3) * 16;
#pragma unroll
        for (int k = 0; k < 16; ++k) {
          const int e = __builtin_amdgcn_readlane(enx, base1 + k);
          ubuf[k] = *(const u32x4*)(ub8 + (size_t)e * 1024);
        }
      }
      float a8[8], a4[4], a2[2], tot;
      {
        const bool up = (lane & 32) != 0;
#pragma unroll
        for (int i = 0; i < 8; ++i) { float send = up ? acc[i] : acc[i + 8]; float keep = up ? acc[i + 8] : acc[i]; a8[i] = keep + __shfl_xor(send, 32); }
      }
      {
        const bool up = (lane & 16) != 0;
#pragma unroll
        for (int i = 0; i < 4; ++i) { float send = up ? a8[i] : a8[i + 4]; float keep = up ? a8[i + 4] : a8[i]; a4[i] = keep + __shfl_xor(send, 16); }
      }
      {
        const bool up = (lane & 8) != 0;
#pragma unroll
        for (int i = 0; i < 2; ++i) { float send = up ? a4[i] : a4[i + 2]; float keep = up ? a4[i + 2] : a4[i]; a2[i] = keep + __shfl_xor(send, 8); }
      }
      {
        const bool up = (lane & 4) != 0;
        float send = up ? a2[0] : a2[1]; float keep = up ? a2[1] : a2[0]; tot = keep + __shfl_xor(send, 4);
      }
      tot += __shfl_xor(tot, 2);
      tot += __shfl_xor(tot, 1);
      const float sucur = (h < 4) ? suA : suB;
      const float gscur = (h < 4) ? gsA : gsB;
      const float suk = __shfl(sucur, base + (lane >> 2));
      const float gsk = __shfl(gscur, base + (lane >> 2));
      const float coef = gsk * gelu_tanh(suk * tot);
      if ((lane & 3) == 0) coefbuf[(size_t)T * 128 + h * 16 + (lane >> 2)] = coef;
    }
  }
}

#define XB_TMO      128
#define XB_XCNT(j)  (256  + 64 * (j))
#define XB_XSUB(j)  (1280 + 64 * (j))
#define XB_XGEN(j)  (2304 + 64 * (j))
#define XB_TOP      3328
#define XB_TOPGEN   3392
#define XCD_BAR_WORDS 3456
#define XB_SPIN_CAP (1u << 18)
#define LAS __attribute__((address_space(3)))

__device__ __forceinline__ unsigned xb_ld(unsigned* p)              { return __hip_atomic_load(p, __ATOMIC_RELAXED, __HIP_MEMORY_SCOPE_AGENT); }
__device__ __forceinline__ unsigned xb_add(unsigned* p, unsigned v) { return __hip_atomic_fetch_add(p, v, __ATOMIC_RELAXED, __HIP_MEMORY_SCOPE_AGENT); }
__device__ __forceinline__ unsigned xb_xcc_id() { return (unsigned)__builtin_amdgcn_s_getreg((3 << 11) | 20) & 0xFu; }
#define XB_SPIN(cond, bar) do { unsigned _sp = 0; while (cond) { __builtin_amdgcn_s_sleep(1); \
    if ((++_sp & 255u) == 0u) { if (xb_ld(&(bar)[XB_TMO])) break; if (_sp > XB_SPIN_CAP) { atomicAdd(&(bar)[XB_TMO], 1u); break; } } } } while (0)

struct XcdBarrier {
    unsigned* bar; unsigned x;
    volatile LAS unsigned* st;
};

__device__ __forceinline__ XcdBarrier xcd_barrier_post(unsigned* bar, volatile LAS unsigned* st) {
    XcdBarrier b; b.bar = bar; b.x = xb_xcc_id(); b.st = st;
    if (threadIdx.x == 0) (void)xb_add(&bar[XB_XCNT(b.x)], 1u);
    return b;
}
__device__ __forceinline__ void xcd_barrier_complete(unsigned* bar, unsigned x, unsigned& nloc, unsigned& nx) {
    const unsigned G = gridDim.x * gridDim.y * gridDim.z;
    unsigned sum, cnt, mine, sp = 0u;
    for (;;) {
        sum = 0u; cnt = 0u; mine = 0u;
#pragma unroll
        for (unsigned j = 0; j < 16; ++j) { const unsigned c = xb_ld(&bar[XB_XCNT(j)]); sum += c; cnt += (c > 0u) ? 1u : 0u; mine = (j == x) ? c : mine; }
        if (sum == G) break;
        __builtin_amdgcn_s_sleep(1);
        if ((++sp & 255u) == 0u) { if (xb_ld(&bar[XB_TMO])) break; if (sp > XB_SPIN_CAP) { atomicAdd(&bar[XB_TMO], 1u); break; } }
    }
    nloc = mine > 0u ? mine : 1u; nx = cnt > 0u ? cnt : 1u;
}

__device__ __forceinline__ void xcd_barrier(const XcdBarrier& b) {
    asm volatile("s_waitcnt vmcnt(0)" ::: "memory");
    __syncthreads();
    if (threadIdx.x == 0) {
        unsigned* bar = b.bar;
        __builtin_amdgcn_s_waitcnt(0);
        unsigned nloc = b.st[0], nx = b.st[1];
        if (nloc == 0u) { xcd_barrier_complete(bar, b.x, nloc, nx); b.st[0] = nloc; b.st[1] = nx; }
        const unsigned old = xb_add(&bar[XB_XSUB(b.x)], 1u);
        const unsigned gen = old / nloc;
        if (old + 1u == (gen + 1u) * nloc) {
            __builtin_amdgcn_fence(__ATOMIC_RELEASE, "agent");
            asm volatile("s_waitcnt vmcnt(0)" ::: "memory");
            const unsigned og = xb_add(&bar[XB_TOP], 1u);
            const unsigned tg = og / nx;
            if (og + 1u == (tg + 1u) * nx) xb_add(&bar[XB_TOPGEN], 1u);
            else XB_SPIN(xb_ld(&bar[XB_TOPGEN]) == tg, bar);
            __builtin_amdgcn_fence(__ATOMIC_ACQUIRE, "agent");
            xb_add(&bar[XB_XGEN(b.x)], 1u);
            asm volatile("s_waitcnt vmcnt(0)" ::: "memory");
        } else {
            XB_SPIN(xb_ld(&bar[XB_XGEN(b.x)]) == gen, bar);
            __builtin_amdgcn_fence(__ATOMIC_ACQUIRE, "agent");
            asm volatile("s_waitcnt vmcnt(0)" ::: "memory");
        }
    }
    __syncthreads();
}


struct SliceMap { int q, nx, rank, nloc; };
__device__ __forceinline__ SliceMap slice_map(const Params& p, const char* smem) {
  unsigned* cnt = (unsigned*)(p.ws + OFF_BAR) + XCD_BAR_WORDS;
  const unsigned x = xb_xcc_id();
  SliceMap m; m.q = 0; m.nx = 0; m.nloc = 1;
#pragma unroll
  for (unsigned j = 0; j < 16; ++j) {
    const unsigned c = xb_ld(&cnt[64 * j]);
    if (c > 0u) { if (j < x) ++m.q; ++m.nx; }
    if (j == x) m.nloc = (int)c;
  }
  m.rank = (int)((const volatile unsigned*)(smem + 131072))[4];
  if (m.nx < 1) m.nx = 1; if (m.nloc < 1) m.nloc = 1;
  return m;
}
__device__ void phase_peer_u_slice(const Params& p, const int slice, const int wv, const int nwv);
__device__ void phase_peer_v_slice(const Params& p, const int slice, const int wv, const int nwv);
__device__ void phase_peer_u(const Params& p, const char* smem) {
  const SliceMap sm = slice_map(p, smem);
  for (int slice = sm.q; slice < 8; slice += sm.nx) phase_peer_u_slice(p, slice, sm.rank * 8 + (threadIdx.x >> 6), sm.nloc * 8);
}
#define PU_IDX16(idx_)                                                                                                   \
  _Pragma("unroll") for (int k = 0; k < 16; ++k) {                                                                      \
    if (maskA != 0ull) { idx_[k] = __ffsll((long long)maskA) - 1; maskA &= maskA - 1ull; }                              \
    else if (maskB != 0ull) { idx_[k] = 64 + __ffsll((long long)maskB) - 1; maskB &= maskB - 1ull; }                    \
    else idx_[k] = -1;                                                                                                  \
  }
#define PU_LOAD16(buf_, idx_)                                                                                           \
  _Pragma("unroll") for (int k = 0; k < 16; ++k) {                                                                      \
    buf_[k] = (u32x4){0u, 0u, 0u, 0u};                                                                                  \
    if (idx_[k] >= 0) {                                                                                                 \
      const int e = (idx_[k] < 64) ? __builtin_amdgcn_readlane((int)eA.x, idx_[k]) : __builtin_amdgcn_readlane((int)eB.x, idx_[k] - 64); \
      buf_[k] = *(const u32x4*)(ub8 + (size_t)e * 1024);                                                                \
    }                                                                                                                   \
  }
#define PU_COMPUTE16(buf_, idx_)                                                                                        \
  {                                                                                                                     \
    float acc[16];                                                                                                      \
    _Pragma("unroll") for (int k = 0; k < 16; ++k) {                                                                    \
      const u32x4 a = buf_[k];                                                                                          \
      f32x2 s2 = hf[0] * CVT8(a[0], false);                                                                             \
      s2 = __builtin_elementwise_fma(hf[1], CVT8(a[0], true), s2);                                                      \
      s2 = __builtin_elementwise_fma(hf[2], CVT8(a[1], false), s2);                                                     \
      s2 = __builtin_elementwise_fma(hf[3], CVT8(a[1], true), s2);                                                      \
      s2 = __builtin_elementwise_fma(hf[4], CVT8(a[2], false), s2);                                                     \
      s2 = __builtin_elementwise_fma(hf[5], CVT8(a[2], true), s2);                                                      \
      s2 = __builtin_elementwise_fma(hf[6], CVT8(a[3], false), s2);                                                     \
      s2 = __builtin_elementwise_fma(hf[7], CVT8(a[3], true), s2);                                                      \
      acc[k] = s2.x + s2.y;                                                                                             \
    }                                                                                                                   \
    float a8[8], a4[4], a2[2], tot;                                                                                     \
    { const bool up = (lane & 32) != 0;                                                                                 \
      _Pragma("unroll") for (int i = 0; i < 8; ++i) { float send = up ? acc[i] : acc[i + 8]; float keep = up ? acc[i + 8] : acc[i]; a8[i] = keep + __shfl_xor(send, 32); } } \
    { const bool up = (lane & 16) != 0;                                                                                 \
      _Pragma("unroll") for (int i = 0; i < 4; ++i) { float send = up ? a8[i] : a8[i + 4]; float keep = up ? a8[i + 4] : a8[i]; a4[i] = keep + __shfl_xor(send, 16); } } \
    { const bool up = (lane & 8) != 0;                                                                                  \
      _Pragma("unroll") for (int i = 0; i < 2; ++i) { float send = up ? a4[i] : a4[i + 2]; float keep = up ? a4[i + 2] : a4[i]; a2[i] = keep + __shfl_xor(send, 8); } } \
    { const bool up = (lane & 4) != 0; float send = up ? a2[0] : a2[1]; float keep = up ? a2[1] : a2[0]; tot = keep + __shfl_xor(send, 4); } \
    tot += __shfl_xor(tot, 2);                                                                                          \
    tot += __shfl_xor(tot, 1);                                                                                          \
    const int totb = (int)__float_as_uint(tot);                                                                         \
    _Pragma("unroll") for (int k = 0; k < 16; ++k) {                                                                    \
      if (idx_[k] >= 0) {                                                                                               \
        const int v = __builtin_amdgcn_readlane(totb, 4 * k);                                                           \
        if (idx_[k] < 64) resA = (lane == idx_[k]) ? v : resA;                                                          \
        else resB = (lane == idx_[k] - 64) ? v : resB;                                                                  \
      }                                                                                                                 \
    }                                                                                                                   \
  }

__device__ void phase_peer_u_slice(const Params& p, const int slice, const int wv, const int nwv) {
  const int lane = threadIdx.x & 63;
  const u16* h2 = (const u16*)(p.ws + OFF_RA);
  const char* ub8 = p.ws + OFF_UB + lane * 16;
  const float* su = (const float*)(p.ws + OFF_UB + (16ull << 20));
  const float* sv = (const float*)(p.ws + OFF_VB + (16ull << 20));
  const uint2* eg = (const uint2*)(p.ws + OFF_RB);
  float* coefbuf = (float*)(p.ws + OFF_RB + (64ull << 20));
  if (wv >= NT) return;
  uint2 eAn = eg[(size_t)wv * 128 + lane], eBn = eg[(size_t)wv * 128 + 64 + lane];
  u32x4 hAn = *(const u32x4*)(h2 + (size_t)wv * D + lane * 16), hBn = *(const u32x4*)(h2 + (size_t)wv * D + lane * 16 + 8);
  for (int T = wv; T < NT; T += nwv) {
    const uint2 eA = eAn, eB = eBn;
    f32x2 hf[8];
    hf[0] = (f32x2){bflo(hAn[0]), bfhi(hAn[0])}; hf[1] = (f32x2){bflo(hAn[1]), bfhi(hAn[1])};
    hf[2] = (f32x2){bflo(hAn[2]), bfhi(hAn[2])}; hf[3] = (f32x2){bflo(hAn[3]), bfhi(hAn[3])};
    hf[4] = (f32x2){bflo(hBn[0]), bfhi(hBn[0])}; hf[5] = (f32x2){bflo(hBn[1]), bfhi(hBn[1])};
    hf[6] = (f32x2){bflo(hBn[2]), bfhi(hBn[2])}; hf[7] = (f32x2){bflo(hBn[3]), bfhi(hBn[3])};
    const bool mA = ((int)(eA.x >> 11) == slice), mB = ((int)(eB.x >> 11) == slice);
    unsigned long long maskA = __ballot(mA), maskB = __ballot(mB);
    int resA = 0, resB = 0;
    float suA = 0.f, svA = 0.f, suB = 0.f, svB = 0.f;
    bool first = true;
    do {
      int idx1[16];
      u32x4 buf1[16];
      PU_IDX16(idx1)
      PU_LOAD16(buf1, idx1)
      if (first) {
        first = false;
        if (mA) { suA = su[eA.x]; svA = sv[eA.x]; }
        if (mB) { suB = su[eB.x]; svB = sv[eB.x]; }
        const int Tn = (T + nwv < NT) ? T + nwv : T;
        eAn = eg[(size_t)Tn * 128 + lane]; eBn = eg[(size_t)Tn * 128 + 64 + lane];
        hAn = *(const u32x4*)(h2 + (size_t)Tn * D + lane * 16); hBn = *(const u32x4*)(h2 + (size_t)Tn * D + lane * 16 + 8);
      }
      PU_COMPUTE16(buf1, idx1)
    } while ((maskA | maskB) != 0ull);
    if (mA) { const float c = __uint_as_float(eA.y) * svA * gelu_tanh(suA * __uint_as_float((unsigned)resA)); coefbuf[(size_t)T * 128 + lane] = c; }
    if (mB) { const float c = __uint_as_float(eB.y) * svB * gelu_tanh(suB * __uint_as_float((unsigned)resB)); coefbuf[(size_t)T * 128 + 64 + lane] = c; }
  }
}

__device__ void phase_peer_v(const Params& p, const char* smem) {
  const SliceMap sm = slice_map(p, smem);
  for (int slice = sm.q; slice < 8; slice += sm.nx) phase_peer_v_slice(p, slice, sm.rank * 8 + (threadIdx.x >> 6), sm.nloc * 8);
}
#define PV_GATHER(rows_, pr_)                                                                  \
  _Pragma("unroll") for (int s2 = 0; s2 < 16; ++s2) {                                          \
    const unsigned e = (s2 & 1) ? (pr_[s2 >> 3][(s2 >> 1) & 3] >> 16) : (pr_[s2 >> 3][(s2 >> 1) & 3] & 0xFFFFu); \
    rows_[s2] = *(const u32x4*)(vbase + (e * 128u + coff));                                    \
  }
#define PV_LOADIDS(pr_, T_)                                                                    \
  _Pragma("unroll") for (int m = 0; m < 2; ++m) pr_[m] = *(const u32x4*)(eid16 + ((size_t)(T_) * 8 + g) * 2 + m);
#define PV_LOADCF(cf_, T_)                                                                     \
  _Pragma("unroll") for (int m = 0; m < 4; ++m) cf_[m] = *(const u32x4*)(coefbuf + (size_t)(T_) * 128 + g * 16 + 4 * m);
#define PV_COMPUTE_STORE(rows_, cf_, x1_, T_)                                                  \
  {                                                                                            \
    f32x2 o[8];                                                                                \
    _Pragma("unroll") for (int i = 0; i < 8; ++i) o[i] = (f32x2){0.f, 0.f};                    \
    _Pragma("unroll") for (int s2 = 0; s2 < 16; ++s2) {                                        \
      const float ck = __uint_as_float(cf_[s2 >> 2][s2 & 3]);                                  \
      const f32x2 ck2 = (f32x2){ck, ck};                                                       \
      const u32x4 a = rows_[s2];                                                               \
      o[0] = __builtin_elementwise_fma(ck2, CVT8(a[0], false), o[0]);                          \
      o[1] = __builtin_elementwise_fma(ck2, CVT8(a[0], true), o[1]);                           \
      o[2] = __builtin_elementwise_fma(ck2, CVT8(a[1], false), o[2]);                          \
      o[3] = __builtin_elementwise_fma(ck2, CVT8(a[1], true), o[3]);                           \
      o[4] = __builtin_elementwise_fma(ck2, CVT8(a[2], false), o[4]);                          \
      o[5] = __builtin_elementwise_fma(ck2, CVT8(a[2], true), o[5]);                           \
      o[6] = __builtin_elementwise_fma(ck2, CVT8(a[3], false), o[6]);                          \
      o[7] = __builtin_elementwise_fma(ck2, CVT8(a[3], true), o[7]);                           \
    }                                                                                          \
    f32x2 r4[4], r2[2], r1;                                                                    \
    { const bool up = (lane & 32) != 0;                                                        \
      _Pragma("unroll") for (int i = 0; i < 4; ++i) {                                          \
        f32x2 send = up ? o[i] : o[i + 4], keep = up ? o[i + 4] : o[i];                        \
        f32x2 rc; rc.x = __shfl_xor(send.x, 32); rc.y = __shfl_xor(send.y, 32);                \
        r4[i] = keep + rc; } }                                                                 \
    { const bool up = (lane & 16) != 0;                                                        \
      _Pragma("unroll") for (int i = 0; i < 2; ++i) {                                          \
        f32x2 send = up ? r4[i] : r4[i + 2], keep = up ? r4[i + 2] : r4[i];                    \
        f32x2 rc; rc.x = __shfl_xor(send.x, 16); rc.y = __shfl_xor(send.y, 16);                \
        r2[i] = keep + rc; } }                                                                 \
    { const bool up = (lane & 8) != 0;                                                         \
      f32x2 send = up ? r2[0] : r2[1], keep = up ? r2[1] : r2[0];                              \
      f32x2 rc; rc.x = __shfl_xor(send.x, 8); rc.y = __shfl_xor(send.y, 8);                    \
      r1 = keep + rc; }                                                                        \
    const f32x2 g2 = *(const f32x2*)(mod + ((T_) >> 14) * 6144 + 5120 + col);                  \
    *(f32x2*)(x2buf + (size_t)(T_) * D + col) = x1_ + g2 * r1;                                 \
  }

#define PV8_IDS(pr_, j_)                                                                         \
  {                                                                                              \
    const int jj_ = ((j_) < NJ) ? (j_) : (NJ - 1);                                               \
    int bt_ = wv + (jj_ >> 3) * nwv; bt_ = (bt_ < NT / 8) ? bt_ : wv;                            \
    const size_t T_ = (size_t)bt_ * 8 + tk;                                                      \
    pr_[0] = eid16[(T_ * 8 + (jj_ & 7)) * 2]; pr_[1] = eid16[(T_ * 8 + (jj_ & 7)) * 2 + 1];      \
  }
#define PV8_GATHER(rows_, pr_)                                                                   \
  _Pragma("unroll") for (int s2 = 0; s2 < 16; ++s2) {                                            \
    const unsigned e = (s2 & 1) ? (pr_[s2 >> 3][(s2 >> 1) & 3] >> 16) : (pr_[s2 >> 3][(s2 >> 1) & 3] & 0xFFFFu); \
    rows_[s2] = *(const u32x4*)(vbase + (e * 128u + coff));                                      \
  }
#define PV8_CHUNK(rows_, j_)                                                                     \
  {                                                                                              \
    const int bt_ = wv + ((j_) >> 3) * nwv;                                                      \
    const bool live_ = (bt_ < NT / 8);                                                           \
    const size_t T_ = (size_t)(live_ ? bt_ : wv) * 8 + tk;                                       \
    u32x4 cf_[4];                                                                                \
    _Pragma("unroll") for (int m = 0; m < 4; ++m) cf_[m] = *(const u32x4*)(coefbuf + T_ * 128 + ((j_) & 7) * 16 + 4 * m); \
    if (((j_) & 7) == 0) { _Pragma("unroll") for (int i = 0; i < 8; ++i) o[i] = (f32x2){0.f, 0.f}; } \
    if (((j_) & 7) == 6) {                                                                       \
      const float* x1p = p.out + T_ * D + col;                                                   \
      _Pragma("unroll") for (int i = 0; i < 4; ++i) { xres[i] = *(const f32x4*)(x1p + 4 * i); } \
    }                                                                                            \
    _Pragma("unroll") for (int s2 = 0; s2 < 16; ++s2) {                                          \
      const float ck = __uint_as_float(cf_[s2 >> 2][s2 & 3]);                                    \
      const f32x2 ck2 = (f32x2){ck, ck};                                                         \
      const u32x4 a = rows_[s2];                                                                 \
      o[0] = __builtin_elementwise_fma(ck2, CVT8(a[0], false), o[0]);                            \
      o[1] = __builtin_elementwise_fma(ck2, CVT8(a[0], true), o[1]);                             \
      o[2] = __builtin_elementwise_fma(ck2, CVT8(a[1], false), o[2]);                            \
      o[3] = __builtin_elementwise_fma(ck2, CVT8(a[1], true), o[3]);                             \
      o[4] = __builtin_elementwise_fma(ck2, CVT8(a[2], false), o[4]);                            \
      o[5] = __builtin_elementwise_fma(ck2, CVT8(a[2], true), o[5]);                             \
      o[6] = __builtin_elementwise_fma(ck2, CVT8(a[3], false), o[6]);                            \
      o[7] = __builtin_elementwise_fma(ck2, CVT8(a[3], true), o[7]);                             \
    }                                                                                            \
    if (((j_) & 7) == 7 && live_) {                                                              \
      float* x2p = x2buf + T_ * D + col;                                                         \
      const float* g2p = mod + (int)(T_ >> 14) * 6144 + 5120 + col;                              \
      _Pragma("unroll") for (int i = 0; i < 4; ++i) {                                            \
        const f32x4 xv = xres[i], gv = *(const f32x4*)(g2p + 4 * i);                                                  \
        f32x4 r_; r_[0] = xv[0] + gv[0] * o[2 * i].x; r_[1] = xv[1] + gv[1] * o[2 * i].y;        \
        r_[2] = xv[2] + gv[2] * o[2 * i + 1].x; r_[3] = xv[3] + gv[3] * o[2 * i + 1].y;          \
        *(f32x4*)(x2p + 4 * i) = r_;                                                             \
      }                                                                                          \
    }                                                                                            \
  }

__device__ void phase_peer_v_slice(const Params& p, const int slice, const int wv, const int nwv) {
  const int lane = threadIdx.x & 63;
  const int tk = lane >> 3, ci = lane & 7;
  const char* vbase = p.ws + OFF_VB + (size_t)slice * (16384ull * 128);
  const unsigned coff = ci * 16;
  const u32x4* eid16 = (const u32x4*)(p.ws + OFF_RB + (48ull << 20));
  const float* mod = (const float*)(p.ws + OFF_MOD);
  const float* coefbuf = (const float*)(p.ws + OFF_RB + (64ull << 20));
  float* x2buf = (float*)(p.ws + OFF_RC);
  if (wv >= NT / 8) return;
  const int col = slice * 128 + ci * 16;
  const int nbatch = (NT / 8 - wv + nwv - 1) / nwv;
  const int NJ = nbatch * 8;
  u32x4 rowsA[16], rowsB[16], prA[2], prB[2];
  f32x2 o[8];
  f32x4 xres[4];
  PV8_IDS(prA, 0)
  PV8_GATHER(rowsA, prA)
  PV8_IDS(prB, 1)
  for (int j = 0; j < NJ; j += 2) {
    PV8_GATHER(rowsB, prB)
    PV8_IDS(prA, j + 2)
    PV8_CHUNK(rowsA, j)
    PV8_GATHER(rowsA, prA)
    PV8_IDS(prB, j + 3)
    PV8_CHUNK(rowsB, j + 1)
  }
}

__device__ void phase_final_norm(const Params& p) {
  const int lane = threadIdx.x & 63;
  const int gw = blockIdx.x * 8 + (threadIdx.x >> 6), nw = gridDim.x * 8;
  constexpr int R = 3;
  float4 gq4[4];
#pragma unroll
  for (int i = 0; i < 4; ++i) gq4[i] = ((const float4*)p.norm_f_g)[lane + 64 * i];
  for (int T0 = gw; T0 < NT; T0 += nw * R) {
    float4 v[R][4];
#pragma unroll
    for (int r = 0; r < R; ++r) {
      const int T = (T0 + r * nw < NT) ? T0 + r * nw : T0;
      const float* xs2 = (const float*)(p.ws + OFF_RC) + (size_t)T * D;
#pragma unroll
      for (int i = 0; i < 4; ++i) v[r][i] = ((const float4*)xs2)[lane + 64 * i];
    }
#pragma unroll
    for (int r = 0; r < R; ++r) {
      const int T = T0 + r * nw;
      if (T < NT) {
        float* xr = p.out + (size_t)T * D;
        float ss = 0.f;
#pragma unroll
        for (int i = 0; i < 4; ++i) ss += v[r][i].x * v[r][i].x + v[r][i].y * v[r][i].y + v[r][i].z * v[r][i].z + v[r][i].w * v[r][i].w;
        ss = wave_sum(ss);
        const float rstd = rsqrtf(ss * (1.f / 1024.f) + 1e-6f);
#pragma unroll
        for (int i = 0; i < 4; ++i) {
          const float4 gq = gq4[i];
          ((float4*)xr)[lane + 64 * i] = make_float4(v[r][i].x * rstd * gq.x, v[r][i].y * rstd * gq.y, v[r][i].z * rstd * gq.z, v[r][i].w * rstd * gq.w);
        }
      }
    }
  }
}

constexpr int SMEM_BYTES = 131072 + 64;

__global__ void __launch_bounds__(512, 2) mega(Params p) {
  extern __shared__ __attribute__((aligned(16))) char smem[];
  uint4* xbw = (uint4*)(smem + 131072);
  if (threadIdx.x == 0) *xbw = make_uint4(0u, 0u, 0u, 0u);
  __syncthreads();
  XcdBarrier xb = xcd_barrier_post((unsigned*)(p.ws + OFF_BAR), (volatile LAS unsigned*)xbw);
  if (threadIdx.x == 0) ((unsigned*)(smem + 131072))[4] = xb_add((unsigned*)(p.ws + OFF_BAR) + XCD_BAR_WORDS + 64 * xb.x, 1u);
  if (p.phase_lo < 0) cg::this_grid().sync();
#define RUN_PHASE(ph_, ...)                                         \
  if (p.phase_lo <= (ph_) && (ph_) < p.phase_hi) {                  \
    __VA_ARGS__;                                                    \
    if ((ph_) + 1 < p.phase_hi) xcd_barrier(xb);                    \
  }
  RUN_PHASE(0, phase0(p, smem))
  RUN_PHASE(1, phase_fold(p, smem); phase_norm<false>(p))
  RUN_PHASE(2, phase_gemm1(p, smem))
  RUN_PHASE(3, phase_fft1(p, smem); __syncthreads(); phase_lru_local(p, smem))
  RUN_PHASE(4, phase_carry(p, smem); phase_fft3(p, smem))
  RUN_PHASE(5, phase_lru_fix(p))
  RUN_PHASE(6, phase_gemm2(p, smem))
  RUN_PHASE(7, phase_norm<true>(p))
  RUN_PHASE(8, phase_gemm3(p, smem))
  RUN_PHASE(9, phase_topk(p))
  RUN_PHASE(10, if (U_SLICED) phase_peer_u(p, smem); else phase_peer_u_tm(p))
  RUN_PHASE(11, for (int r_ = 0; r_ < (PROBE == 2 ? 2 : 1); ++r_) phase_peer_v(p, smem))
  RUN_PHASE(12, phase_final_norm(p))
}

extern "C" void kernel_launch(void* const* d_in, const int* in_sizes, int n_in, void* d_out, int out_size,
                              void* d_ws, size_t ws_size, hipStream_t stream) {
  static int grid_blocks = 0;
  if (!grid_blocks) {
    int dev = 0, cus = 0, per_cu = 0;
    (void)hipGetDevice(&dev);
    (void)hipDeviceGetAttribute(&cus, hipDeviceAttributeMultiprocessorCount, dev);
    (void)hipFuncSetAttribute((const void*)mega, hipFuncAttributeMaxDynamicSharedMemorySize, SMEM_BYTES);
    (void)hipOccupancyMaxActiveBlocksPerMultiprocessor(&per_cu, mega, 512, SMEM_BYTES);
    if (per_cu < 1) per_cu = 1;
    grid_blocks = cus;
  }
  if (ws_size < WS_TOTAL) { fprintf(stderr, "workspace too small: %zu < %zu\n", ws_size, (size_t)WS_TOTAL); return; }
  Params p{};
  p.x_prompt = (const float*)d_in[0]; p.x_sample = (const float*)d_in[1]; p.c_prompt = (const float*)d_in[2]; p.c_sample = (const float*)d_in[3];
  p.ada_w = (const float*)d_in[4]; p.ada_b = (const float*)d_in[5]; p.norm1_g = (const float*)d_in[6]; p.w_in = (const float*)d_in[7];
  p.fnet_w = (const float*)d_in[8]; p.conv_w = (const float*)d_in[9]; p.conv_b = (const float*)d_in[10]; p.lru_wa = (const float*)d_in[11];
  p.lru_ba = (const float*)d_in[12]; p.lru_wx = (const float*)d_in[13]; p.lru_bx = (const float*)d_in[14]; p.lru_lambda = (const float*)d_in[15];
  p.w_out = (const float*)d_in[16]; p.norm2_g = (const float*)d_in[17]; p.peer_wq = (const float*)d_in[18]; p.peer_k1 = (const float*)d_in[19];
  p.peer_k2 = (const float*)d_in[20]; p.peer_u = (const float*)d_in[21]; p.peer_v = (const float*)d_in[22]; p.norm_f_g = (const float*)d_in[23];
  p.out = (float*)d_out; p.ws = (char*)d_ws;
#if COOP
  (void)hipMemsetAsync((char*)d_ws + OFF_BAR, 0, (XCD_BAR_WORDS + 64 * 16) * sizeof(unsigned), stream);
  p.phase_lo = 0; p.phase_hi = NPHASE;
  void* args[] = {&p};
  hipError_t e = hipLaunchCooperativeKernel((void*)mega, dim3(grid_blocks), dim3(512), args, SMEM_BYTES, stream);
  if (e != hipSuccess) fprintf(stderr, "cooperative launch failed: %s (grid %d)\n", hipGetErrorString(e), grid_blocks);
#else
  for (int ph = 0; ph < NPHASE; ++ph) {
    p.phase_lo = ph; p.phase_hi = ph + 1;
    hipLaunchKernelGGL(mega, dim3(grid_blocks), dim3(512), SMEM_BYTES, stream, p);
  }
#endif
}
```
